# Optimizing an MI355X kernel written in HIP

```python
import jax, jax.numpy as jnp
from jax import lax
import numpy as np

D_MODEL = 1024
BATCH = 32
SEQ = 2048
DEPTH = 1

N_HEADS = 16
N_KV_HEADS = 4
HEAD_DIM = 64
D_ATTN = N_HEADS * HEAD_DIM
D_KV = N_KV_HEADS * HEAD_DIM
WINDOW = 128
BLOCK = 128
KSPAN = BLOCK + 2 * WINDOW
NEG_INF = -1e30
D_CONV = D_MODEL
CONV_WIDTH = 3
N_EXPERTS = 16
CAPACITY_FACTOR = 2
D_FF_EXPERT = 2048
DEEPNORM_ALPHA = (2.0 * DEPTH) ** 0.25
DEEPNORM_BETA = (8.0 * DEPTH) ** -0.25
LN_EPS = 1e-5
IN_SPLITS = (D_ATTN, D_KV, D_KV, D_CONV, D_CONV, D_CONV, D_MODEL, D_MODEL)
D_IN = sum(IN_SPLITS)
SPLIT_IDX = [int(c) for c in np.cumsum(IN_SPLITS)[:-1]]

kernel_name = "hybrid_conv_swa_ec_moe_deepnorm"


def layer_norm(x, g, b):
    xf = x.astype(jnp.float32)
    mu = xf.mean(-1, keepdims=True)
    var = jnp.square(xf - mu).mean(-1, keepdims=True)
    y = (xf - mu) * lax.rsqrt(var + LN_EPS) * g.astype(jnp.float32) + b.astype(jnp.float32)
    return y.astype(x.dtype)


def alibi_slopes(n_heads):
    return (2.0 ** (-8.0 * np.arange(1, n_heads + 1) / n_heads)).astype(np.float32)


def windowed_gqa(q, k, v, sink):
    B, S, _ = q.shape
    nb = S // BLOCK
    rep = N_HEADS // N_KV_HEADS
    qb = q.reshape(B, nb, BLOCK, N_KV_HEADS, rep, HEAD_DIM).astype(jnp.float32) * (HEAD_DIM ** -0.5)
    qb = jnp.moveaxis(qb, 1, 0)
    pad = ((0, 0), (WINDOW, WINDOW), (0, 0), (0, 0))
    kp = jnp.pad(k.reshape(B, S, N_KV_HEADS, HEAD_DIM).astype(jnp.float32), pad)
    vp = jnp.pad(v.reshape(B, S, N_KV_HEADS, HEAD_DIM).astype(jnp.float32), pad)
    slopes = jnp.asarray(alibi_slopes(N_HEADS)).reshape(N_KV_HEADS, rep)
    i = jnp.arange(BLOCK)[:, None]
    j = jnp.arange(KSPAN)[None, :]
    dist = jnp.abs(i - j + WINDOW)
    bias = -slopes[:, :, None, None] * dist.astype(jnp.float32)
    sink = sink.astype(jnp.float32).reshape(N_KV_HEADS, rep)[None, :, :, None]

    def one_block(args):
        q_blk, n = args
        start = n * BLOCK
        k_blk = lax.dynamic_slice_in_dim(kp, start, KSPAN, axis=1)
        v_blk = lax.dynamic_slice_in_dim(vp, start, KSPAN, axis=1)
        kpos = start - WINDOW + j
        valid = (dist <= WINDOW) & (kpos >= 0) & (kpos < S)
        s = jnp.einsum('bqgrd,bkgd->bgrqk', q_blk, k_blk) + bias
        s = jnp.where(valid, s, NEG_INF)
        m = jnp.maximum(s.max(-1), sink)
        p = jnp.exp(s - m[..., None])
        denom = p.sum(-1) + jnp.exp(sink - m)
        return jnp.einsum('bgrqk,bkgd->bqgrd', p / denom[..., None], v_blk)

    o = lax.map(one_block, (qb, jnp.arange(nb)))
    return jnp.moveaxis(o, 0, 1).reshape(B, S, D_ATTN).astype(q.dtype)


def short_conv(b_gate, c_gate, xc, conv_w):
    u = c_gate * xc
    S = u.shape[1]
    up = jnp.pad(u, ((0, 0), (CONV_WIDTH // 2, CONV_WIDTH // 2), (0, 0)))
    y = conv_w[0] * up[:, 0:S]
    for w in range(1, CONV_WIDTH):
        y = y + conv_w[w] * up[:, w:w + S]
    return b_gate * y


def hybrid_mixer(x, w_in, conv_w, attn_sink, w_attn_o, w_conv_o, w_out):
    proj = x @ w_in
    q, k, v, cb, cc, cx, ga, gc = jnp.split(proj, SPLIT_IDX, axis=-1)
    y_attn = windowed_gqa(q, k, v, attn_sink) @ w_attn_o
    y_conv = short_conv(cb, cc, cx, conv_w) @ w_conv_o
    merged = jax.nn.sigmoid(ga) * y_attn + jax.nn.sigmoid(gc) * y_conv
    return merged @ w_out


def expert_choice_moe(x, w_router, w_gate, w_up, w_down):
    B, S, _ = x.shape
    cap = CAPACITY_FACTOR * S // N_EXPERTS
    logits = jnp.einsum('bsd,de->bse', x, w_router).astype(jnp.float32)
    aff = jax.nn.softmax(logits, axis=-1)
    top_val, top_idx = lax.top_k(jnp.swapaxes(aff, 1, 2), cap)
    b_idx = jnp.arange(B)[:, None, None]
    xe = x[b_idx, top_idx]
    h = jax.nn.silu(jnp.einsum('becd,edf->becf', xe, w_gate)) * jnp.einsum('becd,edf->becf', xe, w_up)
    ye = jnp.einsum('becf,efd->becd', h, w_down) * top_val[..., None].astype(x.dtype)
    return jnp.zeros_like(x).at[b_idx, top_idx].add(ye)


def setup_inputs(seed: int = 0) -> dict:
    key = jax.random.key(seed)
    ks = jax.random.split(key, 18)
    f32 = jnp.float32
    nrm = lambda k, s: jax.random.normal(k, s, f32)
    L = DEPTH
    col_scale = np.ones((D_IN,), np.float32)
    col_scale[D_ATTN + D_KV:D_ATTN + 2 * D_KV] = DEEPNORM_BETA
    w_in = nrm(ks[3], (L, D_MODEL, D_IN)) * (D_MODEL ** -0.5) * jnp.asarray(col_scale)
    return {
        "x": nrm(ks[0], (BATCH, SEQ, D_MODEL)),
        "ln0_g": 1.0 + 0.02 * nrm(ks[1], (D_MODEL,)),
        "ln0_b": 0.02 * nrm(ks[2], (D_MODEL,)),
        "w_in": w_in,
        "conv_w": nrm(ks[4], (L, CONV_WIDTH, D_CONV)) * (CONV_WIDTH ** -0.5),
        "attn_sink": 0.5 * nrm(ks[5], (L, N_HEADS)),
        "w_attn_o": nrm(ks[6], (L, D_ATTN, D_MODEL)) * (D_ATTN ** -0.5) * DEEPNORM_BETA,
        "w_conv_o": nrm(ks[7], (L, D_CONV, D_MODEL)) * (D_CONV ** -0.5) * DEEPNORM_BETA,
        "w_out": nrm(ks[8], (L, D_MODEL, D_MODEL)) * (D_MODEL ** -0.5) * DEEPNORM_BETA,
        "ln1_g": 1.0 + 0.02 * nrm(ks[9], (L, D_MODEL)),
        "ln1_b": 0.02 * nrm(ks[10], (L, D_MODEL)),
        "w_router": nrm(ks[11], (L, D_MODEL, N_EXPERTS)) * (D_MODEL ** -0.5),
        "w_gate": nrm(ks[12], (L, N_EXPERTS, D_MODEL, D_FF_EXPERT)) * (D_MODEL ** -0.5),
        "w_up": nrm(ks[13], (L, N_EXPERTS, D_MODEL, D_FF_EXPERT)) * (D_MODEL ** -0.5),
        "w_down": nrm(ks[14], (L, N_EXPERTS, D_FF_EXPERT, D_MODEL)) * (D_FF_EXPERT ** -0.5) * DEEPNORM_BETA,
        "ln2_g": 1.0 + 0.02 * nrm(ks[15], (L, D_MODEL)),
        "ln2_b": 0.02 * nrm(ks[16], (L, D_MODEL)),
    }


def reference(x, ln0_g, ln0_b, w_in, conv_w, attn_sink, w_attn_o, w_conv_o, w_out,
              ln1_g, ln1_b, w_router, w_gate, w_up, w_down, ln2_g, ln2_b):
    x = layer_norm(x, ln0_g, ln0_b)
    for l in range(DEPTH):
        h = hybrid_mixer(x, w_in[l], conv_w[l], attn_sink[l], w_attn_o[l], w_conv_o[l], w_out[l])
        x = layer_norm(DEEPNORM_ALPHA * x + h, ln1_g[l], ln1_b[l])
        f = expert_choice_moe(x, w_router[l], w_gate[l], w_up[l], w_down[l])
        x = layer_norm(DEEPNORM_ALPHA * x + f, ln2_g[l], ln2_b[l])
    return x
```

```cpp
#include <hip/hip_runtime.h>
#include <cstdio>
#include <cstdint>

#ifndef ONE_LAUNCH
#define ONE_LAUNCH 0
#endif

namespace pg8 {
#define PG8_LAS __attribute__((address_space(3)))
typedef unsigned short bf16_t;
typedef short bf16x8 __attribute__((ext_vector_type(8)));
typedef float f32x4 __attribute__((ext_vector_type(4)));
typedef unsigned u32x4 __attribute__((ext_vector_type(4)));
constexpr int BM = 256, BK = 64, HALF = 128, HTB = HALF * BK * 2  , STAGE_BYTES = 8 * HTB, NXCD = 8, WGM = 8;

__host__ __device__ __forceinline__ int lds_byte(int r, int c) { const int st = (r >> 4) * 2 + (c >> 5), rr = r & 15, cc = c & 31, ob = rr * 64 + cc * 2; return st * 1024 + (ob ^ (((ob >> 9) & 1) << 5)); }
__host__ __device__ __forceinline__ void stage_rc(int b, int& R, int& C) { const int st = b / 1024, sb = b % 1024, swz = sb ^ (((sb >> 9) & 1) << 5); R = (st >> 1) * 16 + swz / 64; C = (st & 1) * 32 + (swz % 64) / 2; }
__host__ __device__ __forceinline__ int perm32(int rho) { const int n = rho >> 4, i = rho & 15; return 8 * (i >> 2) + 4 * n + (i & 3); }

struct Unit { int pm, pn, pb; };
struct Gemm { const bf16_t* A; const bf16_t* Bt; int lda, ldb, K; };

struct StaticOrder {
    int nM, nN, nwg, G, c, gshift, pb0;
    __device__ void init(int M, int N, int G_, int c_, int gshift_ = 30, int pb0_ = 0) { nM = M / BM; nN = N / BM; nwg = nM * nN; G = G_; c = c_; gshift = gshift_; pb0 = pb0_; }
    __device__ bool next(int i, Unit& u) const {
        const long L = (long)i * G + c; if (L >= nwg) return false;
        int wgid = (int)L; { const int q = nwg / NXCD, r = nwg % NXCD, xcd = wgid % NXCD, off = wgid / NXCD; wgid = (xcd < r ? xcd * (q + 1) : r * (q + 1) + (xcd - r) * q) + off; }
        const int nig = WGM * nN, gid = wgid / nig, fm = gid * WGM, gsz = (nM - fm) < WGM ? (nM - fm) : WGM;
        u.pm = fm + ((wgid % nig) % gsz); u.pn = (wgid % nig) / gsz; u.pb = (u.pm >> gshift) * nN + pb0 + u.pn; return true;
    }
};

__device__ __forceinline__ unsigned cvt_pk_bf16(float lo, float hi) { unsigned r; asm volatile("v_cvt_pk_bf16_f32 %0, %1, %2" : "=v"(r) : "v"(lo), "v"(hi)); return r; }

template <class Epi, class Sched, bool ALIGN_EPI = false>
__device__ __forceinline__ void gemm_phase(PG8_LAS unsigned char* lds, const Gemm g, const Sched& S, const Epi& E) {
    int tid_ = threadIdx.x; asm volatile("" : "+v"(tid_));
    const int tid = tid_, wid = __builtin_amdgcn_readfirstlane(tid >> 6), lane = tid & 63, wr = wid >> 2, wc = wid & 3, fr = lane & 15, fq = lane >> 4;
    const int K = g.K, nt = K / BK;
    unsigned voffA[2], voffB[2];
#pragma unroll
    for (int i = 0; i < 2; ++i) { int R, C; stage_rc(tid * 16 + i * 8192, R, C); const int Rb = Epi::PERM ? ((R & ~31) + perm32(R & 31)) : R;
        voffA[i] = (unsigned)(R * g.lda + C) * 2u; voffB[i] = (unsigned)(Rb * g.ldb + C) * 2u; }
    const size_t kstep = (size_t)(BK * 2);
    const size_t hstepA = (size_t)HALF * g.lda * 2, hstepB = (size_t)HALF * g.ldb * 2;
    const size_t tstepA = 2 * hstepA, tstepB = 2 * hstepB;
    const unsigned ldsw = (unsigned)wid * 1024u;
    const int aoff = lds_byte(wr * 64 + fr, fq * 8), boff = lds_byte(wc * 32 + fr, fq * 8);
#define PG8_SA(b, h) (((b) * 2 + (h)) * HTB)
#define PG8_SB(b, h) ((4 + (b) * 2 + (h)) * HTB)
#define PG8_STAGE(bufoff, gbase, voff) do { _Pragma("unroll") for (int _i = 0; _i < 2; ++_i) \
        __builtin_amdgcn_global_load_lds((const unsigned*)((const char*)(gbase) + (voff)[_i]), (PG8_LAS unsigned*)(lds + (bufoff) + ldsw + _i * 8192), 16, 0, 0); } while (0)
#define PG8_LDA(dst, b, h) do { _Pragma("unroll") for (int m = 0; m < 4; ++m) _Pragma("unroll") for (int k = 0; k < 2; ++k) dst[m][k] = *(const PG8_LAS bf16x8*)(lds + PG8_SA(b, h) + aoff + m * 2048 + k * 1024); } while (0)
#define PG8_LDB(dst, b, h) do { _Pragma("unroll") for (int n = 0; n < 2; ++n) _Pragma("unroll") for (int k = 0; k < 2; ++k) dst[n][k] = *(const PG8_LAS bf16x8*)(lds + PG8_SB(b, h) + boff + n * 2048 + k * 1024); } while (0)
#define PG8_MMA(ai, bj, At, Bt) do { __builtin_amdgcn_s_setprio(1); _Pragma("unroll") for (int m = 0; m < 4; ++m) _Pragma("unroll") for (int n = 0; n < 2; ++n) _Pragma("unroll") for (int k = 0; k < 2; ++k) \
        acc[ai][bj][m][n] = __builtin_amdgcn_mfma_f32_16x16x32_bf16(Bt[n][k], At[m][k], acc[ai][bj][m][n], 0, 0, 0); __builtin_amdgcn_s_setprio(0); } while (0)
#define PG8_WAIT_V(n) asm volatile("s_waitcnt vmcnt(" #n ")" ::: "memory")
#define PG8_WAIT_L(n) asm volatile("s_waitcnt lgkmcnt(" #n ")" ::: "memory")
#define PG8_BAR __builtin_amdgcn_s_barrier()
#define PG8_SCHED __builtin_amdgcn_sched_barrier(0)
    Unit cur, nxt; int ui = 0;
    if (!S.next(0, cur)) return;
    f32x4 acc[2][2][4][2];
#pragma unroll
    for (int a = 0; a < 2; ++a)
#pragma unroll
        for (int b = 0; b < 2; ++b)
#pragma unroll
            for (int m = 0; m < 4; ++m)
#pragma unroll
                for (int n = 0; n < 2; ++n) acc[a][b][m][n] = (f32x4){0.f, 0.f, 0.f, 0.f};
    bf16x8 At[4][2], B0[2][2], B1[2][2];
    const char* cA = (const char*)g.A + (size_t)cur.pm * tstepA; const char* cB = (const char*)g.Bt + (size_t)cur.pb * tstepB;
    PG8_STAGE(PG8_SB(0, 0), cB, voffB); PG8_STAGE(PG8_SB(0, 1), cB + hstepB, voffB); PG8_STAGE(PG8_SA(0, 0), cA, voffA); PG8_STAGE(PG8_SA(0, 1), cA + hstepA, voffA);
    if (wr == 1) PG8_BAR;
    PG8_WAIT_V(2); PG8_BAR;
    PG8_STAGE(PG8_SB(1, 0), cB + kstep, voffB); PG8_STAGE(PG8_SA(1, 0), cA + kstep, voffA); PG8_STAGE(PG8_SB(1, 1), cB + hstepB + kstep, voffB);
    PG8_WAIT_V(6); PG8_BAR;
    for (;;) {
        const bool has_next = S.next(ui + 1, nxt);
        const char* nA = has_next ? (const char*)g.A + (size_t)nxt.pm * tstepA : cA; const char* nB = has_next ? (const char*)g.Bt + (size_t)nxt.pb * tstepB : cB;
        for (int t = 0; t < nt; t += 2) {
            const bool last = (t == nt - 2);
            const char* a1 = cA + (size_t)(t + 1) * kstep;
            const char* a2 = last ? nA : cA + (size_t)(t + 2) * kstep; const char* b2 = last ? nB : cB + (size_t)(t + 2) * kstep;
            const char* a3 = a2 + kstep; const char* b3 = b2 + kstep;
            PG8_LDB(B0, 0, 0); PG8_LDB(B1, 0, 1); PG8_SCHED; PG8_LDA(At, 0, 0); PG8_STAGE(PG8_SA(1, 1), a1 + hstepA, voffA);
            PG8_WAIT_V(8); PG8_WAIT_L(0); PG8_BAR; PG8_MMA(0, 0, At, B0); PG8_MMA(0, 1, At, B1); PG8_BAR; PG8_SCHED;
            PG8_LDA(At, 0, 1); PG8_STAGE(PG8_SB(0, 0), b2, voffB); PG8_STAGE(PG8_SB(0, 1), b2 + hstepB, voffB); PG8_STAGE(PG8_SA(0, 0), a2, voffA);
            PG8_WAIT_V(8); PG8_WAIT_L(0); PG8_BAR; PG8_MMA(1, 0, At, B0); PG8_MMA(1, 1, At, B1); PG8_BAR; PG8_SCHED;
            PG8_LDB(B0, 1, 0); PG8_LDB(B1, 1, 1); PG8_SCHED; PG8_LDA(At, 1, 0); PG8_STAGE(PG8_SA(0, 1), a2 + hstepA, voffA);
            PG8_WAIT_V(8); PG8_WAIT_L(0); PG8_BAR; PG8_MMA(0, 0, At, B0); PG8_MMA(0, 1, At, B1); PG8_BAR; PG8_SCHED;
            PG8_LDA(At, 1, 1); PG8_STAGE(PG8_SB(1, 0), b3, voffB); PG8_STAGE(PG8_SB(1, 1), b3 + hstepB, voffB); PG8_STAGE(PG8_SA(1, 0), a3, voffA);
            PG8_WAIT_V(8); PG8_WAIT_L(0); PG8_BAR; PG8_MMA(1, 0, At, B0); PG8_MMA(1, 1, At, B1); PG8_BAR; PG8_SCHED;
        }
        if constexpr (ALIGN_EPI) { if (wr == 0) PG8_BAR; }
        E(acc, cur, wr, wc, fr, fq);
        if (!has_next) break;
#pragma unroll
        for (int a = 0; a < 2; ++a)
#pragma unroll
            for (int b = 0; b < 2; ++b)
#pragma unroll
                for (int m = 0; m < 4; ++m)
#pragma unroll
                    for (int n = 0; n < 2; ++n) acc[a][b][m][n] = (f32x4){0.f, 0.f, 0.f, 0.f};
        cur = nxt; cA = nA; cB = nB; ++ui;
        if constexpr (ALIGN_EPI) { if (wr == 1) PG8_BAR; }
    }
    PG8_WAIT_V(0);
    if constexpr (!ALIGN_EPI) { if (wr == 0) PG8_BAR; }
    PG8_BAR;
#undef PG8_SA
#undef PG8_SB
#undef PG8_STAGE
#undef PG8_LDA
#undef PG8_LDB
#undef PG8_MMA
#undef PG8_WAIT_V
#undef PG8_WAIT_L
#undef PG8_BAR
#undef PG8_SCHED
}
}

constexpr int NWAVES = 8;
constexpr int BATCH = 32, SEQ = 2048, DM = 1024, T = BATCH * SEQ, DIN = 6656;
constexpr int NE = 16, CAP = 256, DFF = 2048;
constexpr int OQ = 0, OK_ = 1024, OV = 1280, OCB = 1536, OCC = 2560, OCX = 3584, OGA = 4608, OGC = 5632;
constexpr int NCHUNK = 2, CBATCH = BATCH / NCHUNK, TC = CBATCH * SEQ;
constexpr int NEC = 2, EC = NE / NEC, MC = EC * BATCH * CAP;
constexpr float LN_EPS = 1e-5f, ALPHA = 1.189207115002721f, LOG2E = 1.4426950408889634f;
constexpr float QSCALE = 0.125f * LOG2E;

constexpr size_t MiB = 1u << 20;
constexpr size_t WS_CTL = 0, CTL_ZERO_BYTES = 64 * 1024;
constexpr size_t WS_STATS0 = 1 * MiB;
constexpr size_t WS_STATS1 = WS_STATS0 + 512 * 1024;
constexpr size_t WS_TOKIDX = 2 * MiB;
constexpr size_t WS_TOPVAL = WS_TOKIDX + 512 * 1024;
constexpr size_t WS_INV = 3 * MiB;
constexpr size_t WS_AFF = 5 * MiB;
constexpr size_t WS_WIN = 9 * MiB;
constexpr size_t WS_WAC = 22 * MiB;
constexpr size_t WS_WOUT = 26 * MiB;
constexpr size_t WS_WGU = 32 * MiB;
constexpr size_t WS_WDN = 160 * MiB;
constexpr size_t WS_XN = 224 * MiB;
constexpr size_t WS_MIX = 352 * MiB;
constexpr size_t WS_PROJ = WS_MIX;
constexpr size_t WS_AC = WS_PROJ + 416 * MiB;
constexpr size_t WS_TMP = WS_AC + 128 * MiB;
constexpr size_t WS_XE = WS_MIX;
constexpr size_t WS_H = WS_XE + 256 * MiB;
constexpr size_t WS_END = 960 * MiB;
static_assert(WS_TMP + (size_t)TC * DM * 2 <= WS_END && WS_H + (size_t)MC * DFF * 2 <= WS_END, "ws map");
static_assert(WS_PROJ + (size_t)TC * DIN * 2 <= WS_AC && WS_XN + (size_t)T * DM * 2 <= WS_MIX && WS_WDN + (size_t)NE * DM * DFF * 2 <= WS_XN, "ws map");

constexpr int CW_BAR = 4096;
constexpr int RING_BYTES = 131072, MISC_OFF = RING_BYTES + 320, LDS_BYTES = 147456;

#define GAS __attribute__((address_space(1)))
#define LAS __attribute__((address_space(3)))
typedef unsigned short bf16;
typedef unsigned v4u __attribute__((ext_vector_type(4)));
typedef unsigned v2u __attribute__((ext_vector_type(2)));
typedef float f32x4 __attribute__((ext_vector_type(4)));
typedef float f32x2 __attribute__((ext_vector_type(2)));
typedef float f32x16 __attribute__((ext_vector_type(16)));
typedef short bf16x8 __attribute__((ext_vector_type(8)));
typedef short s16x4 __attribute__((ext_vector_type(4)));
#define LDS_WAIT() asm volatile("s_waitcnt lgkmcnt(0)" ::: "memory")
__device__ __forceinline__ unsigned f2bf(float f) { unsigned u = __builtin_bit_cast(unsigned, f); return (u + 0x7fffu + ((u >> 16) & 1u)) >> 16; }
__device__ __forceinline__ unsigned pk2(float lo, float hi) { return f2bf(lo) | (f2bf(hi) << 16); }
__device__ __forceinline__ float bflo(unsigned u) { return __uint_as_float(u << 16); }
__device__ __forceinline__ float bfhi(unsigned u) { return __uint_as_float(u & 0xffff0000u); }
__device__ __forceinline__ float sigmoidf_(float x) { return __builtin_amdgcn_rcpf(1.0f + __expf(-x)); }

#define XB_TMO      128
#define XB_XCNT(j)  (256  + 64 * (j))
#define XB_XSUB(j)  (1280 + 64 * (j))
#define XB_XGEN(j)  (2304 + 64 * (j))
#define XB_TOP      3328
#define XB_TOPGEN   3392
#define XCD_BAR_WORDS 3456
#define XB_SPIN_CAP (1u << 22)
__device__ __forceinline__ unsigned xb_ld(unsigned* p)              { return __hip_atomic_load(p, __ATOMIC_RELAXED, __HIP_MEMORY_SCOPE_AGENT); }
__device__ __forceinline__ unsigned xb_add(unsigned* p, unsigned v) { return __hip_atomic_fetch_add(p, v, __ATOMIC_RELAXED, __HIP_MEMORY_SCOPE_AGENT); }
__device__ __forceinline__ unsigned xb_xcc_id() { return (unsigned)__builtin_amdgcn_s_getreg((3 << 11) | 20) & 0xFu; }
#define XB_SPIN(cond, bar) do { unsigned _sp = 0; while (cond) { __builtin_amdgcn_s_sleep(1); \
    if ((++_sp & 255u) == 0u) { if (xb_ld(&(bar)[XB_TMO])) break; if (_sp > XB_SPIN_CAP) { atomicAdd(&(bar)[XB_TMO], 1u); break; } } } } while (0)
struct XcdBarrier { unsigned* bar; unsigned x; volatile LAS unsigned* st; };
__device__ __forceinline__ XcdBarrier xcd_barrier_post(unsigned* bar, volatile LAS unsigned* st) {
    XcdBarrier b; b.bar = bar; b.x = xb_xcc_id(); b.st = st;
    if (threadIdx.x == 0) (void)xb_add(&bar[XB_XCNT(b.x)], 1u);
    return b;
}
__device__ __forceinline__ void xcd_barrier_complete(unsigned* bar, unsigned x, unsigned& nloc, unsigned& nx) {
    const unsigned G = gridDim.x * gridDim.y * gridDim.z;
    unsigned sum, cnt, mine, sp = 0u;
    for (;;) {
        sum = 0u; cnt = 0u; mine = 0u;
#pragma unroll
        for (unsigned j = 0; j < 16; ++j) { const unsigned c = xb_ld(&bar[XB_XCNT(j)]); sum += c; cnt += (c > 0u) ? 1u : 0u; mine = (j == x) ? c : mine; }
        if (sum == G) break;
        __builtin_amdgcn_s_sleep(1);
        if ((++sp & 255u) == 0u) { if (xb_ld(&bar[XB_TMO])) break; if (sp > XB_SPIN_CAP) { atomicAdd(&bar[XB_TMO], 1u); break; } }
    }
    nloc = mine > 0u ? mine : 1u; nx = cnt > 0u ? cnt : 1u;
}
__device__ __forceinline__ void xcd_barrier(const XcdBarrier& b) {
    asm volatile("s_waitcnt vmcnt(0)" ::: "memory");
    __syncthreads();
    if (threadIdx.x == 0) {
        unsigned* bar = b.bar;
        __builtin_amdgcn_s_waitcnt(0);
        unsigned nloc = b.st[0], nx = b.st[1];
        if (nloc == 0u) { xcd_barrier_complete(bar, b.x, nloc, nx); b.st[0] = nloc; b.st[1] = nx; }
        const unsigned old = xb_add(&bar[XB_XSUB(b.x)], 1u);
        const unsigned gen = old / nloc;
        if (old + 1u == (gen + 1u) * nloc) {
            __builtin_amdgcn_fence(__ATOMIC_RELEASE, "agent");
            asm volatile("s_waitcnt vmcnt(0)" ::: "memory");
            const unsigned og = xb_add(&bar[XB_TOP], 1u);
            const unsigned tg = og / nx;
            if (og + 1u == (tg + 1u) * nx) xb_add(&bar[XB_TOPGEN], 1u);
            else XB_SPIN(xb_ld(&bar[XB_TOPGEN]) == tg, bar);
            __builtin_amdgcn_fence(__ATOMIC_ACQUIRE, "agent");
            xb_add(&bar[XB_XGEN(b.x)], 1u);
            asm volatile("s_waitcnt vmcnt(0)" ::: "memory");
        } else {
            XB_SPIN(xb_ld(&bar[XB_XGEN(b.x)]) == gen, bar);
            __builtin_amdgcn_fence(__ATOMIC_ACQUIRE, "agent");
            asm volatile("s_waitcnt vmcnt(0)" ::: "memory");
        }
    }
    __syncthreads();
}

__device__ __forceinline__ float wave_sum(float v) {
#pragma unroll
    for (int o = 1; o < 64; o <<= 1) v += __shfl_xor(v, o);
    return v;
}

using pg8::Unit; using pg8::bf16_t;
struct EpiProj {
    static constexpr bool PERM = true;
    bf16* O;
    __device__ __forceinline__ void operator()(const f32x4 (&acc)[2][2][4][2], const Unit& u, int wr, int wc, int fr, int fq) const {
        const int row0 = u.pm * 256 + wr * 64 + fr, col0 = u.pn * 256 + wc * 32 + 8 * fq; const float sc = (u.pn < 4) ? QSCALE : 1.f;
#pragma unroll
        for (int ai = 0; ai < 2; ++ai)
#pragma unroll
            for (int m = 0; m < 4; ++m) { bf16* rowp = O + (size_t)(row0 + ai * 128 + m * 16) * DIN + col0;
#pragma unroll
                for (int bj = 0; bj < 2; ++bj) { const f32x4 v0 = acc[ai][bj][m][0] * sc, v1 = acc[ai][bj][m][1] * sc; v4u w;
                    w.x = pg8::cvt_pk_bf16(v0[0], v0[1]); w.y = pg8::cvt_pk_bf16(v0[2], v0[3]); w.z = pg8::cvt_pk_bf16(v1[0], v1[1]); w.w = pg8::cvt_pk_bf16(v1[2], v1[3]);
                    *(v4u*)(rowp + bj * 128) = w; } }
    }
};
template <int MODE> struct EpiGate {
    static constexpr bool PERM = true;
    const bf16* proj; bf16* tmp; int gcol0;
    __device__ __forceinline__ void operator()(const f32x4 (&acc)[2][2][4][2], const Unit& u, int wr, int wc, int fr, int fq) const {
        const int row0 = u.pm * 256 + wr * 64 + fr, col0 = u.pn * 256 + wc * 32 + 8 * fq;
#pragma unroll
        for (int ai = 0; ai < 2; ++ai)
#pragma unroll
            for (int m = 0; m < 4; ++m) { const size_t row = (size_t)(row0 + ai * 128 + m * 16);
#pragma unroll
                for (int bj = 0; bj < 2; ++bj) { const int col = col0 + bj * 128;
                    const v4u gv = *(const v4u*)(proj + row * DIN + gcol0 + col);
                    const f32x4 a0 = acc[ai][bj][m][0], a1 = acc[ai][bj][m][1];
                    float r[8];
                    r[0] = sigmoidf_(bflo(gv.x)) * a0[0]; r[1] = sigmoidf_(bfhi(gv.x)) * a0[1]; r[2] = sigmoidf_(bflo(gv.y)) * a0[2]; r[3] = sigmoidf_(bfhi(gv.y)) * a0[3];
                    r[4] = sigmoidf_(bflo(gv.z)) * a1[0]; r[5] = sigmoidf_(bfhi(gv.z)) * a1[1]; r[6] = sigmoidf_(bflo(gv.w)) * a1[2]; r[7] = sigmoidf_(bfhi(gv.w)) * a1[3];
                    bf16* op = tmp + row * DM + col;
                    if (MODE == 1) { const v4u tv = *(const v4u*)op;
                        r[0] += bflo(tv.x); r[1] += bfhi(tv.x); r[2] += bflo(tv.y); r[3] += bfhi(tv.y); r[4] += bflo(tv.z); r[5] += bfhi(tv.z); r[6] += bflo(tv.w); r[7] += bfhi(tv.w); }
                    v4u w; w.x = pg8::cvt_pk_bf16(r[0], r[1]); w.y = pg8::cvt_pk_bf16(r[2], r[3]); w.z = pg8::cvt_pk_bf16(r[4], r[5]); w.w = pg8::cvt_pk_bf16(r[6], r[7]);
                    *(v4u*)op = w; } }
    }
};
struct EpiResid {
    static constexpr bool PERM = false;
    const float* x; const float* stats0; const float* g0; const float* b0; float* out; int row_off;
    __device__ __forceinline__ void operator()(const f32x4 (&acc)[2][2][4][2], const Unit& u, int wr, int wc, int fr, int fq) const {
        const int row0 = row_off + u.pm * 256 + wr * 64 + fr, col0 = u.pn * 256 + wc * 32 + 4 * fq;
        f32x2 st[2][4];
#pragma unroll
        for (int ai = 0; ai < 2; ++ai)
#pragma unroll
            for (int m = 0; m < 4; ++m) st[ai][m] = *(const f32x2*)(stats0 + (size_t)(row0 + ai * 128 + m * 16) * 2);
#pragma unroll
        for (int bj = 0; bj < 2; ++bj)
#pragma unroll
            for (int n = 0; n < 2; ++n) { const int col = col0 + bj * 128 + n * 16; const f32x4 gv = *(const f32x4*)(g0 + col), bv = *(const f32x4*)(b0 + col);
#pragma unroll
                for (int ai = 0; ai < 2; ++ai)
#pragma unroll
                    for (int m = 0; m < 4; ++m) { const size_t off = (size_t)(row0 + ai * 128 + m * 16) * DM + col;
                        const f32x4 xv = *(const f32x4*)(x + off);
                        const f32x4 xn = (xv - st[ai][m].x) * st[ai][m].y * gv + bv;
                        *(f32x4*)(out + off) = xn * ALPHA + acc[ai][bj][m][n]; } }
    }
};
struct EpiSwiglu {
    static constexpr bool PERM = true;
    bf16* H;
    __device__ __forceinline__ void operator()(const f32x4 (&acc)[2][2][4][2], const Unit& u, int wr, int wc, int fr, int fq) const {
        const int row0 = u.pm * 256 + wr * 64 + fr, col0 = u.pn * 128 + wc * 32 + 8 * fq;
#pragma unroll
        for (int ai = 0; ai < 2; ++ai)
#pragma unroll
            for (int m = 0; m < 4; ++m) { float r[8];
#pragma unroll
                for (int n = 0; n < 2; ++n)
#pragma unroll
                    for (int j = 0; j < 4; ++j) { const float gte = acc[ai][0][m][n][j], up = acc[ai][1][m][n][j]; r[n * 4 + j] = gte * sigmoidf_(gte) * up; }
                v4u w; w.x = pg8::cvt_pk_bf16(r[0], r[1]); w.y = pg8::cvt_pk_bf16(r[2], r[3]); w.z = pg8::cvt_pk_bf16(r[4], r[5]); w.w = pg8::cvt_pk_bf16(r[6], r[7]);
                *(v4u*)(H + (size_t)(row0 + ai * 128 + m * 16) * DFF + col0) = w; }
    }
};
struct EpiDown {
    static constexpr bool PERM = true;
    bf16* Y; const float* topval;
    __device__ __forceinline__ void operator()(const f32x4 (&acc)[2][2][4][2], const Unit& u, int wr, int wc, int fr, int fq) const {
        const int row0 = u.pm * 256 + wr * 64 + fr, col0 = u.pn * 256 + wc * 32 + 8 * fq;
#pragma unroll
        for (int ai = 0; ai < 2; ++ai)
#pragma unroll
            for (int m = 0; m < 4; ++m) { const int row = row0 + ai * 128 + m * 16; const float tv = topval[row]; bf16* rowp = Y + (size_t)row * DM + col0;
#pragma unroll
                for (int bj = 0; bj < 2; ++bj) { const f32x4 v0 = acc[ai][bj][m][0] * tv, v1 = acc[ai][bj][m][1] * tv; v4u w;
                    w.x = pg8::cvt_pk_bf16(v0[0], v0[1]); w.y = pg8::cvt_pk_bf16(v0[2], v0[3]); w.z = pg8::cvt_pk_bf16(v1[0], v1[1]); w.w = pg8::cvt_pk_bf16(v1[2], v1[3]);
                    *(v4u*)(rowp + bj * 128) = w; } }
    }
};

__device__ __forceinline__ void transpose_item(const float* __restrict__ Wblk, int N, bf16* dst, int ldo, LAS float* scr, int lane) {
#pragma unroll 8
    for (int i = 0; i < 32; ++i) { const int kk = 2 * i + (lane >> 5); scr[kk * 33 + (lane & 31)] = Wblk[(size_t)kk * N + (lane & 31)]; }
    LDS_WAIT(); asm volatile("" ::: "memory");
    const int c = lane & 7;
#pragma unroll
    for (int j = 0; j < 4; ++j) { const int n = (lane >> 3) + 8 * j; const LAS float* s = scr + (8 * c) * 33 + n;
        v4u o; o.x = pk2(s[0 * 33], s[1 * 33]); o.y = pk2(s[2 * 33], s[3 * 33]); o.z = pk2(s[4 * 33], s[5 * 33]); o.w = pk2(s[6 * 33], s[7 * 33]);
        *(v4u*)(dst + (size_t)n * ldo + 8 * c) = o; }
    LDS_WAIT(); asm volatile("" ::: "memory");
}

struct Args { const float* in[17]; float* out; unsigned char* ws; int lo, hi; };
#define CAS __attribute__((address_space(4)))
__device__ __forceinline__ const void* karg(int byte_off) {
    const CAS char* kp = (const CAS char*)__builtin_amdgcn_kernarg_segment_ptr(); asm volatile("" : "+s"(kp)); return *(const void* const CAS*)(kp + byte_off); }

__device__ __forceinline__ f32x16 mfma32(bf16x8 a, bf16x8 b, f32x16 c) { return __builtin_amdgcn_mfma_f32_32x32x16_bf16(a, b, c, 0, 0, 0); }
__device__ __forceinline__ s16x4 vtr(LAS unsigned char* p) { return __builtin_bit_cast(s16x4, __builtin_amdgcn_ds_read_tr16_b64_v4i16((LAS s16x4*)p)); }
__device__ __forceinline__ void attn_unit(LAS unsigned char* lds, const bf16* __restrict__ proj, bf16* __restrict__ ac, const float* __restrict__ sink,
                                          int bl, int n, int g, int tid, int lane, int wave) {
    const int s_base = n * 128 - 128;
#pragma unroll
    for (int i = 0; i < 6; ++i) {
        const int p = tid + 512 * i, row = p >> 3, ch = p & 7, s = s_base + row;
        v4u kv = (v4u){0u, 0u, 0u, 0u}, vv = (v4u){0u, 0u, 0u, 0u};
        if (s >= 0 && s < SEQ) { const bf16* src = proj + (size_t)(bl * SEQ + s) * DIN + OK_ + g * 64 + ch * 8; kv = *(const v4u*)src; vv = *(const v4u*)(src + (OV - OK_)); }
        *(LAS v4u*)(lds + row * 128 + ((ch ^ ((row >> 1) & 7)) << 4)) = kv;
        *(LAS v4u*)(lds + 49152 + row * 128 + ((ch ^ (((row >> 1) & 1) << 2)) << 4)) = vv;
    }
    __syncthreads();
    const int ql = lane & 31, h5 = lane >> 5, rb = wave & 3, hp = wave >> 2;
    const int tq = n * 128 + rb * 32 + ql;
    const bf16* qrow = proj + (size_t)(bl * SEQ + tq) * DIN;
    bf16x8 qf[2][4];
    f32x16 o[2][2];
    float m_[2], l_[2], slope2[2];
#pragma unroll
    for (int hh = 0; hh < 2; ++hh) {
        const int head = 4 * g + 2 * hp + hh;
#pragma unroll
        for (int ks = 0; ks < 4; ++ks) qf[hh][ks] = *(const bf16x8*)(qrow + head * 64 + 16 * ks + 8 * h5);
#pragma unroll
        for (int r = 0; r < 16; ++r) { o[hh][0][r] = 0.f; o[hh][1][r] = 0.f; }
        m_[hh] = sink[head] * LOG2E; l_[hh] = (h5 == 0) ? 1.f : 0.f;
        slope2[hh] = exp2f(-0.5f * (float)(head + 1)) * LOG2E;
    }
    const int sw = (ql >> 1) & 7;
    int koff[4];
#pragma unroll
    for (int ks = 0; ks < 4; ++ks) koff[ks] = ql * 128 + (((2 * ks + h5) ^ sw) << 4);
    const int i16 = lane & 15, g16 = (lane >> 4) & 1, bsw = (lane >> 3) & 1;
    const int vb0 = 49152 + (4 * h5 + (i16 >> 2)) * 128 + ((((2 * g16) + ((i16 & 3) >> 1)) ^ (4 * bsw)) << 4) + (i16 & 1) * 8;
    const int vb1 = vb0 ^ 64;
#pragma unroll 1
    for (int d = 0; d < 9; ++d) {
        const int kb = rb + d;
        if ((n == 0 && kb < 4) || (n == SEQ / 128 - 1 && kb >= 8)) continue;
        bf16x8 kf[4], vf[2][2];
#pragma unroll
        for (int ks = 0; ks < 4; ++ks) kf[ks] = *(const LAS bf16x8*)(lds + kb * 4096 + koff[ks]);
#pragma unroll
        for (int s = 0; s < 2; ++s) {
            const s16x4 a0 = vtr(lds + vb0 + kb * 4096 + s * 2048), a1 = vtr(lds + vb0 + kb * 4096 + s * 2048 + 1024);
            const s16x4 c0 = vtr(lds + vb1 + kb * 4096 + s * 2048), c1 = vtr(lds + vb1 + kb * 4096 + s * 2048 + 1024);
            vf[0][s] = __builtin_shufflevector(a0, a1, 0, 1, 2, 3, 4, 5, 6, 7);
            vf[1][s] = __builtin_shufflevector(c0, c1, 0, 1, 2, 3, 4, 5, 6, 7);
        }
        const float basef = (float)(128 - 32 * d + ql - 4 * h5);
        const bool edge = (d == 0) || (d == 8);
#pragma unroll
        for (int hh = 0; hh < 2; ++hh) {
            f32x16 S;
#pragma unroll
            for (int r = 0; r < 16; ++r) S[r] = 0.f;
#pragma unroll
            for (int ks = 0; ks < 4; ++ks) S = mfma32(kf[ks], qf[hh][ks], S);
            float mb = -INFINITY;
#pragma unroll
            for (int r = 0; r < 16; ++r) {
                const float dist = fabsf(basef - (float)((r & 3) + 8 * (r >> 2)));
                float sv = S[r] - slope2[hh] * dist;
                if (edge && dist > 128.f) sv = -INFINITY;
                S[r] = sv; mb = fmaxf(mb, sv);
            }
            mb = fmaxf(mb, __shfl_xor(mb, 32));
            const float mn = fmaxf(m_[hh], mb), alpha = __builtin_amdgcn_exp2f(m_[hh] - mn);
            m_[hh] = mn;
            float ls = 0.f;
#pragma unroll
            for (int r = 0; r < 16; ++r) { const float p = __builtin_amdgcn_exp2f(S[r] - mn); S[r] = p; ls += p; }
            l_[hh] = l_[hh] * alpha + ls;
#pragma unroll
            for (int r = 0; r < 16; ++r) { o[hh][0][r] *= alpha; o[hh][1][r] *= alpha; }
            bf16x8 pf[2];
#pragma unroll
            for (int s = 0; s < 2; ++s) { v4u w; w.x = pg8::cvt_pk_bf16(S[8 * s + 0], S[8 * s + 1]); w.y = pg8::cvt_pk_bf16(S[8 * s + 2], S[8 * s + 3]);
                w.z = pg8::cvt_pk_bf16(S[8 * s + 4], S[8 * s + 5]); w.w = pg8::cvt_pk_bf16(S[8 * s + 6], S[8 * s + 7]); pf[s] = __builtin_bit_cast(bf16x8, w); }
#pragma unroll
            for (int tl = 0; tl < 2; ++tl)
#pragma unroll
                for (int s = 0; s < 2; ++s) o[hh][tl] = mfma32(vf[tl][s], pf[s], o[hh][tl]);
        }
    }
#pragma unroll
    for (int hh = 0; hh < 2; ++hh) {
        const int head = 4 * g + 2 * hp + hh;
        const float lt = l_[hh] + __shfl_xor(l_[hh], 32), inv = 1.0f / lt;
        bf16* orow = ac + (size_t)(bl * SEQ + tq) * (2 * DM) + head * 64 + 4 * h5;
#pragma unroll
        for (int tl = 0; tl < 2; ++tl)
#pragma unroll
            for (int rr = 0; rr < 4; ++rr) { v2u w; w.x = pg8::cvt_pk_bf16(o[hh][tl][4 * rr] * inv, o[hh][tl][4 * rr + 1] * inv); w.y = pg8::cvt_pk_bf16(o[hh][tl][4 * rr + 2] * inv, o[hh][tl][4 * rr + 3] * inv);
                *(v2u*)(orow + 32 * tl + 8 * rr) = w; }
    }
    __syncthreads();
}

__global__ void __launch_bounds__(NWAVES * 64, 2) hybrid_fwd(Args args) {
    extern __shared__ __attribute__((aligned(16))) unsigned char lds_raw[];
    LAS unsigned char* lds = (LAS unsigned char*)lds_raw;
    volatile LAS unsigned* MISC = (volatile LAS unsigned*)(lds + MISC_OFF);
    const int G = gridDim.x; const int bx = blockIdx.x; const int vcu = (G % 8 == 0) ? (bx % 8) * (G / 8) + bx / 8 : bx; const int NGW = G * NWAVES;
#define KARG(T_, off) ((T_)karg(off))
#define IN_(i) KARG(const float*, 8 * (i))
#define OUT_() KARG(float*, 136)
#define WSP(T_, off) ((T_)((unsigned char*)karg(144) + (off)))

    for (int u = threadIdx.x; u < (LDS_BYTES - RING_BYTES) / 4; u += NWAVES * 64) ((LAS unsigned*)(lds + RING_BYTES))[u] = 0u;
    __syncthreads();
    const int lo = args.lo, hi = args.hi;
    XcdBarrier bar; bar.bar = WSP(unsigned*, WS_CTL) + CW_BAR; bar.x = 0; bar.st = nullptr;
    if (hi - lo > 1) bar = xcd_barrier_post(WSP(unsigned*, WS_CTL) + CW_BAR, MISC + 8);
    int s = 0;
#define STEP_BEGIN if (lo <= s && s < hi) { int tid_ = threadIdx.x; asm volatile("" : "+v"(tid_)); const int tid = tid_, lane = tid & 63, wave = __builtin_amdgcn_readfirstlane(tid >> 6), gw = vcu * NWAVES + wave; (void)lane; (void)gw;
#define STEP_END   if (s + 1 < hi) xcd_barrier(bar); } ++s;

    STEP_BEGIN
    {
        LAS float* scr = (LAS float*)(lds + wave * 16384);
        constexpr int I_IN = (DM / 64) * (DIN / 32), I_SQ = (DM / 64) * (DM / 32), I_GU = (DM / 64) * (DFF / 32), I_DN = (DFF / 64) * (DM / 32);
        constexpr int NITEMS = I_IN + 3 * I_SQ + NE * (2 * I_GU + I_DN);
        for (int it = gw; it < NITEMS; it += NGW) {
            int r = it;
            if (r < I_IN) { const int nblk = DIN / 32, kb = r / nblk, nb = r % nblk; transpose_item(IN_(3) + (size_t)(64 * kb) * DIN + 32 * nb, DIN, WSP(bf16*, WS_WIN) + (size_t)(32 * nb) * DM + 64 * kb, DM, scr, lane); continue; } r -= I_IN;
            if (r < 3 * I_SQ) { const int which = r / I_SQ, q = r % I_SQ, nblk = DM / 32, kb = q / nblk, nb = q % nblk;
                const float* W = which == 0 ? IN_(6) : (which == 1 ? IN_(7) : IN_(8));
                bf16* dst = which == 2 ? WSP(bf16*, WS_WOUT) + (size_t)(32 * nb) * DM + 64 * kb : WSP(bf16*, WS_WAC) + (size_t)(32 * nb) * (2 * DM) + which * DM + 64 * kb;
                transpose_item(W + (size_t)(64 * kb) * DM + 32 * nb, DM, dst, which == 2 ? DM : 2 * DM, scr, lane); continue; } r -= 3 * I_SQ;
            const int e = r / (2 * I_GU + I_DN); r -= e * (2 * I_GU + I_DN);
            if (r < 2 * I_GU) { const int which = r / I_GU, q = r % I_GU, nblk = DFF / 32, kb = q / nblk, nb = q % nblk, n0 = 32 * nb;
                const float* W = (which == 0 ? IN_(12) : IN_(13)) + (size_t)e * DM * DFF;
                const int orow = (n0 >> 7) * 256 + which * 128 + (n0 & 127);
                transpose_item(W + (size_t)(64 * kb) * DFF + n0, DFF, WSP(bf16*, WS_WGU) + ((size_t)e * (2 * DFF) + orow) * DM + 64 * kb, DM, scr, lane); continue; } r -= 2 * I_GU;
            { const int nblk = DM / 32, kb = r / nblk, nb = r % nblk;
                transpose_item(IN_(14) + (size_t)e * DFF * DM + (size_t)(64 * kb) * DM + 32 * nb, DM, WSP(bf16*, WS_WDN) + ((size_t)e * DM + 32 * nb) * DFF + 64 * kb, DFF, scr, lane); }
        }
        const float* x = IN_(0); const float* ln0_g = IN_(1); const float* ln0_b = IN_(2); float* stats0 = WSP(float*, WS_STATS0); bf16* XN = WSP(bf16*, WS_XN);
        f32x4 gv[4], bv[4];
#pragma unroll
        for (int j = 0; j < 4; ++j) { gv[j] = *(const f32x4*)(ln0_g + 4 * lane + 256 * j); bv[j] = *(const f32x4*)(ln0_b + 4 * lane + 256 * j); }
        for (int m = gw; m < T; m += NGW) {
            const f32x4* xr = (const f32x4*)(x + (size_t)m * DM) + lane;
            f32x4 v[4]; float sm = 0.f;
#pragma unroll
            for (int j = 0; j < 4; ++j) { v[j] = xr[64 * j]; sm += (v[j].x + v[j].y) + (v[j].z + v[j].w); }
            const float mean = wave_sum(sm) * (1.f / DM); float s2 = 0.f;
#pragma unroll
            for (int j = 0; j < 4; ++j) { v[j] = v[j] - mean; s2 += (v[j].x * v[j].x + v[j].y * v[j].y) + (v[j].z * v[j].z + v[j].w * v[j].w); }
            const float rstd = 1.f / sqrtf(wave_sum(s2) * (1.f / DM) + LN_EPS);
            if (lane == 0) *(f32x2*)(stats0 + (size_t)m * 2) = (f32x2){mean, rstd};
            v2u* o8 = (v2u*)(XN + (size_t)m * DM) + lane;
#pragma unroll
            for (int j = 0; j < 4; ++j) { const f32x4 y = v[j] * rstd * gv[j] + bv[j]; v2u w; w.x = pk2(y.x, y.y); w.y = pk2(y.z, y.w); o8[64 * j] = w; }
        }
    }
    STEP_END

#pragma unroll 1
    for (int c = 0; c < NCHUNK; ++c) {
        STEP_BEGIN
        {
            pg8::Gemm g{WSP(bf16*, WS_XN) + (size_t)c * TC * DM, WSP(bf16*, WS_WIN), DM, DM, DM}; pg8::StaticOrder S; S.init(TC, DIN, G, bx);
            EpiProj E{WSP(bf16*, WS_PROJ)};
            pg8::gemm_phase<EpiProj, pg8::StaticOrder, true>(lds, g, S, E);
        }
        STEP_END
        STEP_BEGIN
        {
            const bf16* PROJ = WSP(const bf16*, WS_PROJ); bf16* AC = WSP(bf16*, WS_AC);
            constexpr int NU = CBATCH * (SEQ / 128) * 4;
            { const float* attn_sink = IN_(5);
              for (int u = vcu; u < NU; u += G) attn_unit(lds, PROJ, AC, attn_sink, u >> 6, (u >> 2) & 15, u & 3, tid, lane, wave); }
            const int seg = tid >> 7, cg = tid & 127, ch = cg * 8;
            float w0[8], w1[8], w2[8];
            { const float* conv_w = IN_(4);
#pragma unroll
              for (int j = 0; j < 8; ++j) { w0[j] = conv_w[ch + j]; w1[j] = conv_w[DM + ch + j]; w2[j] = conv_w[2 * DM + ch + j]; } }
            for (int it = vcu; it < TC / 64; it += G) {
                const int t0 = it * 64 + seg * 16;
                const int sq0 = t0 & (SEQ - 1);
                float up[8], uc[8], un[8];
                auto load_u = [&](int trow, int spos, float (&uu)[8]) {
                    if (spos < 0 || spos >= SEQ) {
#pragma unroll
                        for (int j = 0; j < 8; ++j) uu[j] = 0.f; return; }
                    const bf16* p = PROJ + (size_t)trow * DIN + ch; const v4u a = *(const v4u*)(p + OCC), b = *(const v4u*)(p + OCX);
                    uu[0] = bflo(a.x) * bflo(b.x); uu[1] = bfhi(a.x) * bfhi(b.x); uu[2] = bflo(a.y) * bflo(b.y); uu[3] = bfhi(a.y) * bfhi(b.y);
                    uu[4] = bflo(a.z) * bflo(b.z); uu[5] = bfhi(a.z) * bfhi(b.z); uu[6] = bflo(a.w) * bflo(b.w); uu[7] = bfhi(a.w) * bfhi(b.w); };
                load_u(t0 - 1, sq0 - 1, up); load_u(t0, sq0, uc);
#pragma unroll 4
                for (int i = 0; i < 16; ++i) {
                    load_u(t0 + i + 1, sq0 + i + 1, un);
                    const v4u cbv = *(const v4u*)(PROJ + (size_t)(t0 + i) * DIN + OCB + ch);
                    float y[8];
#pragma unroll
                    for (int j = 0; j < 8; ++j) y[j] = w0[j] * up[j] + w1[j] * uc[j] + w2[j] * un[j];
                    y[0] *= bflo(cbv.x); y[1] *= bfhi(cbv.x); y[2] *= bflo(cbv.y); y[3] *= bfhi(cbv.y); y[4] *= bflo(cbv.z); y[5] *= bfhi(cbv.z); y[6] *= bflo(cbv.w); y[7] *= bfhi(cbv.w);
                    v4u w; w.x = pk2(y[0], y[1]); w.y = pk2(y[2], y[3]); w.z = pk2(y[4], y[5]); w.w = pk2(y[6], y[7]);
                    *(v4u*)(AC + (size_t)(t0 + i) * (2 * DM) + DM + ch) = w;
#pragma unroll
                    for (int j = 0; j < 8; ++j) { up[j] = uc[j]; uc[j] = un[j]; }
                }
            }
        }
        STEP_END
        STEP_BEGIN
        {
            { pg8::Gemm g{WSP(bf16*, WS_AC), WSP(bf16*, WS_WAC), 2 * DM, 2 * DM, DM}; pg8::StaticOrder S; S.init(TC, DM, G, bx);
              EpiGate<0> E{WSP(const bf16*, WS_PROJ), WSP(bf16*, WS_TMP), OGA};
              pg8::gemm_phase<EpiGate<0>, pg8::StaticOrder, true>(lds, g, S, E); }
            { pg8::Gemm g{WSP(bf16*, WS_AC) + DM, WSP(bf16*, WS_WAC) + DM, 2 * DM, 2 * DM, DM}; pg8::StaticOrder S; S.init(TC, DM, G, bx);
              EpiGate<1> E{WSP(const bf16*, WS_PROJ), WSP(bf16*, WS_TMP), OGC};
              pg8::gemm_phase<EpiGate<1>, pg8::StaticOrder, true>(lds, g, S, E); }
        }
        STEP_END
        STEP_BEGIN
        {
            pg8::Gemm g{WSP(bf16*, WS_TMP), WSP(bf16*, WS_WOUT), DM, DM, DM}; pg8::StaticOrder S; S.init(TC, DM, G, bx);
            EpiResid E{IN_(0), WSP(const float*, WS_STATS0), IN_(1), IN_(2), OUT_(), c * TC};
            pg8::gemm_phase<EpiResid, pg8::StaticOrder, true>(lds, g, S, E);
        }
        STEP_END
    }

    STEP_BEGIN
    {
        LAS float* wr_l = (LAS float*)lds;
        { const float* w_router = IN_(11);
          for (int i = tid; i < DM * NE; i += NWAVES * 64) { const int k = i >> 4, e = i & 15; wr_l[e * DM + k] = w_router[i]; } }
        __syncthreads();
        const float* ln1_g = IN_(9); const float* ln1_b = IN_(10); const float* yb = OUT_(); float* stats1 = WSP(float*, WS_STATS1); bf16* XN = WSP(bf16*, WS_XN); float* aff = WSP(float*, WS_AFF);
        f32x4 gv[4], bv[4];
#pragma unroll
        for (int j = 0; j < 4; ++j) { gv[j] = *(const f32x4*)(ln1_g + 4 * lane + 256 * j); bv[j] = *(const f32x4*)(ln1_b + 4 * lane + 256 * j); }
        for (int m = gw; m < T; m += NGW) {
            const f32x4* yr = (const f32x4*)(yb + (size_t)m * DM) + lane;
            f32x4 v[4]; float sm = 0.f;
#pragma unroll
            for (int j = 0; j < 4; ++j) { v[j] = yr[64 * j]; sm += (v[j].x + v[j].y) + (v[j].z + v[j].w); }
            const float mean = wave_sum(sm) * (1.f / DM); float s2 = 0.f;
#pragma unroll
            for (int j = 0; j < 4; ++j) { v[j] = v[j] - mean; s2 += (v[j].x * v[j].x + v[j].y * v[j].y) + (v[j].z * v[j].z + v[j].w * v[j].w); }
            const float rstd = 1.f / sqrtf(wave_sum(s2) * (1.f / DM) + LN_EPS);
            if (lane == 0) *(f32x2*)(stats1 + (size_t)m * 2) = (f32x2){mean, rstd};
            v2u* o8 = (v2u*)(XN + (size_t)m * DM) + lane;
#pragma unroll
            for (int j = 0; j < 4; ++j) { v[j] = v[j] * rstd * gv[j] + bv[j]; v2u w; w.x = pk2(v[j].x, v[j].y); w.y = pk2(v[j].z, v[j].w); o8[64 * j] = w; }
            float mine = 0.f;
#pragma unroll 2
            for (int e = 0; e < NE; ++e) { float a = 0.f;
#pragma unroll
                for (int j = 0; j < 4; ++j) { const f32x4 wv = *(const LAS f32x4*)(wr_l + e * DM + 4 * lane + 256 * j); a += (v[j].x * wv.x + v[j].y * wv.y) + (v[j].z * wv.z + v[j].w * wv.w); }
                const float tot = wave_sum(a); mine = (lane == e) ? tot : mine; }
            float mx = mine;
#pragma unroll
            for (int o = 1; o < 16; o <<= 1) mx = fmaxf(mx, __shfl_xor(mx, o));
            const float ex = expf(mine - mx); float den = ex;
#pragma unroll
            for (int o = 1; o < 16; o <<= 1) den += __shfl_xor(den, o);
            if (lane < NE) aff[(size_t)m * NE + lane] = ex / den;
        }
    }
    STEP_END

    STEP_BEGIN
    {
        if (wave < 2) {
            const float* aff = WSP(const float*, WS_AFF); int* tokidx = WSP(int*, WS_TOKIDX); float* topval = WSP(float*, WS_TOPVAL); short* inv = WSP(short*, WS_INV);
            for (int u = vcu * 2 + wave; u < BATCH * NE; u += G * 2) {
                const int b = u >> 4, e = u & 15;
                unsigned key[32];
#pragma unroll
                for (int i = 0; i < 32; ++i) key[i] = __float_as_uint(aff[(size_t)(b * SEQ + lane + 64 * i) * NE + e]);
                unsigned thr = 0u;
                for (int bit = 30; bit >= 0; --bit) {
                    const unsigned cand = thr | (1u << bit); int cnt = 0;
#pragma unroll
                    for (int i = 0; i < 32; ++i) cnt += __popcll(__ballot(key[i] >= cand));
                    if (cnt >= CAP) thr = cand;
                }
                int ngt = 0;
#pragma unroll
                for (int i = 0; i < 32; ++i) ngt += __popcll(__ballot(key[i] > thr));
                const int need = CAP - ngt;
                int selb = 0, tieb = 0;
                const unsigned long long below = (1ull << lane) - 1ull;
                const size_t sbase = ((size_t)e * BATCH + b) * CAP;
#pragma unroll
                for (int i = 0; i < 32; ++i) {
                    const bool gt = key[i] > thr, eq = key[i] == thr;
                    const unsigned long long beq = __ballot(eq);
                    const int trank = tieb + __popcll(beq & below);
                    const bool sel = gt || (eq && trank < need);
                    const unsigned long long bsel = __ballot(sel);
                    const int cpos = selb + __popcll(bsel & below);
                    const int t = lane + 64 * i;
                    if (sel) { tokidx[sbase + cpos] = t; topval[sbase + cpos] = __uint_as_float(key[i]); }
                    inv[(size_t)(b * SEQ + t) * NE + e] = sel ? (short)cpos : (short)-1;
                    selb += __popcll(bsel); tieb += __popcll(beq);
                }
            }
        }
    }
    STEP_END

    STEP_BEGIN
    {
        const int* tokidx = WSP(const int*, WS_TOKIDX); const bf16* XN = WSP(const bf16*, WS_XN); bf16* XE = WSP(bf16*, WS_XE);
        for (int r = gw; r < NE * BATCH * CAP; r += NGW) {
            const int b = (r >> 8) & (BATCH - 1); const int t = tokidx[r];
            const v4u* src = (const v4u*)(XN + (size_t)(b * SEQ + t) * DM) + lane; v4u* dst = (v4u*)(XE + (size_t)r * DM) + lane;
            const v4u a = src[0], c2 = src[64]; dst[0] = a; dst[64] = c2;
        }
    }
    STEP_END

#pragma unroll 1
    for (int ec = 0; ec < NEC; ++ec) {
        STEP_BEGIN
        {
            pg8::Gemm g{WSP(bf16*, WS_XE) + (size_t)ec * MC * DM, WSP(bf16*, WS_WGU), DM, DM, DM}; pg8::StaticOrder S; S.init(MC, 2 * DFF, G, bx, 5, ec * EC * (2 * DFF / 256));
            EpiSwiglu E{WSP(bf16*, WS_H)};
            pg8::gemm_phase<EpiSwiglu, pg8::StaticOrder, true>(lds, g, S, E);
        }
        STEP_END
        STEP_BEGIN
        {
            pg8::Gemm g{WSP(bf16*, WS_H), WSP(bf16*, WS_WDN), DFF, DFF, DFF}; pg8::StaticOrder S; S.init(MC, DM, G, bx, 5, ec * EC * (DM / 256));
            EpiDown E{WSP(bf16*, WS_XE) + (size_t)ec * MC * DM, WSP(const float*, WS_TOPVAL) + (size_t)ec * MC};
            pg8::gemm_phase<EpiDown, pg8::StaticOrder, true>(lds, g, S, E);
        }
        STEP_END
    }

    STEP_BEGIN
    {
        const float* ln1_g = IN_(9); const float* ln1_b = IN_(10); const float* ln2_g = IN_(15); const float* ln2_b = IN_(16);
        float* outp = OUT_(); const float* stats1 = WSP(const float*, WS_STATS1); const short* inv = WSP(const short*, WS_INV); const bf16* YE = WSP(const bf16*, WS_XE);
        f32x4 gv[4], bv[4], g2[4], b2[4];
#pragma unroll
        for (int j = 0; j < 4; ++j) { gv[j] = *(const f32x4*)(ln1_g + 4 * lane + 256 * j); bv[j] = *(const f32x4*)(ln1_b + 4 * lane + 256 * j);
            g2[j] = *(const f32x4*)(ln2_g + 4 * lane + 256 * j); b2[j] = *(const f32x4*)(ln2_b + 4 * lane + 256 * j); }
        for (int m = gw; m < T; m += NGW) {
            f32x4* yr = (f32x4*)(outp + (size_t)m * DM) + lane;
            const f32x2 st = *(const f32x2*)(stats1 + (size_t)m * 2);
            f32x4 v[4];
#pragma unroll
            for (int j = 0; j < 4; ++j) v[j] = ((yr[64 * j] - st.x) * st.y * gv[j] + bv[j]) * ALPHA;
            const int b = m >> 11;
            const int myslot = (lane < NE) ? (int)inv[(size_t)m * NE + lane] : -1;
#pragma unroll 1
            for (int e = 0; e < NE; ++e) {
                const int cpos = __builtin_amdgcn_readlane(myslot, e);
                if (cpos >= 0) {
                    const v2u* yp = (const v2u*)(YE + ((size_t)(e * BATCH + b) * CAP + cpos) * DM) + lane;
#pragma unroll
                    for (int j = 0; j < 4; ++j) { const v2u w = yp[64 * j]; v[j].x += bflo(w.x); v[j].y += bfhi(w.x); v[j].z += bflo(w.y); v[j].w += bfhi(w.y); }
                }
            }
            float sm = 0.f;
#pragma unroll
            for (int j = 0; j < 4; ++j) sm += (v[j].x + v[j].y) + (v[j].z + v[j].w);
            const float mean = wave_sum(sm) * (1.f / DM); float s2 = 0.f;
#pragma unroll
            for (int j = 0; j < 4; ++j) { v[j] = v[j] - mean; s2 += (v[j].x * v[j].x + v[j].y * v[j].y) + (v[j].z * v[j].z + v[j].w * v[j].w); }
            const float rstd = 1.f / sqrtf(wave_sum(s2) * (1.f / DM) + LN_EPS);
#pragma unroll
            for (int j = 0; j < 4; ++j) yr[64 * j] = v[j] * rstd * g2[j] + b2[j];
        }
    }
    STEP_END
#undef STEP_BEGIN
#undef STEP_END
}

constexpr int NSTEPS = 1 + NCHUNK * 4 + 3 + NEC * 2 + 1;

extern "C" void kernel_launch(void* const* d_in, const int* in_sizes, int n_in, void* d_out, int out_size, void* d_ws, size_t ws_size, hipStream_t stream) {
    static int grid = 0;
    if (grid == 0) {
        if (n_in != 17 || in_sizes[0] != T * DM || out_size != T * DM || ws_size < WS_END) { fprintf(stderr, "kernel_launch: unexpected shapes / workspace (%zu < %zu); nothing launched\n", ws_size, (size_t)WS_END); grid = -1; return; }
        int dev = 0, cus = 0, per_cu = 0;
        if (hipGetDevice(&dev) != hipSuccess || hipDeviceGetAttribute(&cus, hipDeviceAttributeMultiprocessorCount, dev) != hipSuccess) { grid = -1; return; }
        if (hipFuncSetAttribute((const void*)hybrid_fwd, hipFuncAttributeMaxDynamicSharedMemorySize, LDS_BYTES) != hipSuccess) { fprintf(stderr, "kernel_launch: hipFuncSetAttribute failed\n"); grid = -1; return; }
        if (hipOccupancyMaxActiveBlocksPerMultiprocessor(&per_cu, (const void*)hybrid_fwd, NWAVES * 64, LDS_BYTES) != hipSuccess || per_cu < 1)
            fprintf(stderr, "kernel_launch: occupancy query reports %d workgroups per CU\n", per_cu);
        (void)hipGetLastError();
        grid = cus;
    }
    if (grid < 0) return;
    (void)hipMemsetAsync((char*)d_ws + WS_CTL, 0, CTL_ZERO_BYTES, stream);
    Args a{};
    for (int i = 0; i < 17; ++i) a.in[i] = (const float*)d_in[i];
    a.out = (float*)d_out; a.ws = (unsigned char*)d_ws;
#if ONE_LAUNCH
    a.lo = 0; a.hi = NSTEPS;
    hipLaunchKernelGGL(hybrid_fwd, dim3(grid), dim3(NWAVES * 64), LDS_BYTES, stream, a);
#else
    for (int st = 0; st < NSTEPS; ++st) { a.lo = st; a.hi = st + 1; hipLaunchKernelGGL(hybrid_fwd, dim3(grid), dim3(NWAVES * 64), LDS_BYTES, stream, a); }
#endif
}
```

```cpp
#include <hip/hip_runtime.h>
#include <cstdio>
#include <cstdint>

#ifndef ONE_LAUNCH
#define ONE_LAUNCH 1
#endif

namespace pg8 {
#define PG8_LAS __attribute__((address_space(3)))
typedef unsigned short bf16_t;
typedef short bf16x8 __attribute__((ext_vector_type(8)));
typedef float f32x4 __attribute__((ext_vector_type(4)));
typedef unsigned u32x4 __attribute__((ext_vector_type(4)));
constexpr int BM = 256, BK = 64, HALF = 128, HTB = HALF * BK * 2  , STAGE_BYTES = 8 * HTB, NXCD = 8, WGM = 8;

__host__ __device__ __forceinline__ int lds_byte(int r, int c) { const int st = (r >> 4) * 2 + (c >> 5), rr = r & 15, cc = c & 31, ob = rr * 64 + cc * 2; return st * 1024 + (ob ^ (((ob >> 9) & 1) << 5)); }
__host__ __device__ __forceinline__ void stage_rc(int b, int& R, int& C) { const int st = b / 1024, sb = b % 1024, swz = sb ^ (((sb >> 9) & 1) << 5); R = (st >> 1) * 16 + swz / 64; C = (st & 1) * 32 + (swz % 64) / 2; }
__host__ __device__ __forceinline__ int perm32(int rho) { const int n = rho >> 4, i = rho & 15; return 8 * (i >> 2) + 4 * n + (i & 3); }

struct Unit { int pm, pn, pb; };
struct Gemm { const bf16_t* A; const bf16_t* Bt; int lda, ldb, K; };

struct StaticOrder {
    int nM, nN, nwg, G, c, gshift, pb0;
    __device__ void init(int M, int N, int G_, int c_, int gshift_ = 30, int pb0_ = 0) { nM = M / BM; nN = N / BM; nwg = nM * nN; G = G_; c = c_; gshift = gshift_; pb0 = pb0_; }
    __device__ bool next(int i, Unit& u) const {
        const long L = (long)i * G + c; if (L >= nwg) return false;
        int wgid = (int)L; { const int q = nwg / NXCD, r = nwg % NXCD, xcd = wgid % NXCD, off = wgid / NXCD; wgid = (xcd < r ? xcd * (q + 1) : r * (q + 1) + (xcd - r) * q) + off; }
        const int nig = WGM * nN, gid = wgid / nig, fm = gid * WGM, gsz = (nM - fm) < WGM ? (nM - fm) : WGM;
        u.pm = fm + ((wgid % nig) % gsz); u.pn = (wgid % nig) / gsz; u.pb = (u.pm >> gshift) * nN + pb0 + u.pn; return true;
    }
};

__device__ __forceinline__ unsigned cvt_pk_bf16(float lo, float hi) { unsigned r; asm volatile("v_cvt_pk_bf16_f32 %0, %1, %2" : "=v"(r) : "v"(lo), "v"(hi)); return r; }

template <class Epi, class Sched, bool ALIGN_EPI = false>
__device__ __forceinline__ void gemm_phase(PG8_LAS unsigned char* lds, const Gemm g, const Sched& S, const Epi& E) {
    int tid_ = threadIdx.x; asm volatile("" : "+v"(tid_));
    const int tid = tid_, wid = __builtin_amdgcn_readfirstlane(tid >> 6), lane = tid & 63, wr = wid >> 2, wc = wid & 3, fr = lane & 15, fq = lane >> 4;
    const int K = g.K, nt = K / BK;
    unsigned voffA[2], voffB[2];
#pragma unroll
    for (int i = 0; i < 2; ++i) { int R, C; stage_rc(tid * 16 + i * 8192, R, C); const int Rb = Epi::PERM ? ((R & ~31) + perm32(R & 31)) : R;
        voffA[i] = (unsigned)(R * g.lda + C) * 2u; voffB[i] = (unsigned)(Rb * g.ldb + C) * 2u; }
    const size_t kstep = (size_t)(BK * 2);
    const size_t hstepA = (size_t)HALF * g.lda * 2, hstepB = (size_t)HALF * g.ldb * 2;
    const size_t tstepA = 2 * hstepA, tstepB = 2 * hstepB;
    const unsigned ldsw = (unsigned)wid * 1024u;
    const int aoff = lds_byte(wr * 64 + fr, fq * 8), boff = lds_byte(wc * 32 + fr, fq * 8);
#define PG8_SA(b, h) (((b) * 2 + (h)) * HTB)
#define PG8_SB(b, h) ((4 + (b) * 2 + (h)) * HTB)
#define PG8_STAGE(bufoff, gbase, voff) do { _Pragma("unroll") for (int _i = 0; _i < 2; ++_i) \
        __builtin_amdgcn_global_load_lds((const unsigned*)((const char*)(gbase) + (voff)[_i]), (PG8_LAS unsigned*)(lds + (bufoff) + ldsw + _i * 8192), 16, 0, 0); } while (0)
#define PG8_LDA(dst, b, h) do { _Pragma("unroll") for (int m = 0; m < 4; ++m) _Pragma("unroll") for (int k = 0; k < 2; ++k) dst[m][k] = *(const PG8_LAS bf16x8*)(lds + PG8_SA(b, h) + aoff + m * 2048 + k * 1024); } while (0)
#define PG8_LDB(dst, b, h) do { _Pragma("unroll") for (int n = 0; n < 2; ++n) _Pragma("unroll") for (int k = 0; k < 2; ++k) dst[n][k] = *(const PG8_LAS bf16x8*)(lds + PG8_SB(b, h) + boff + n * 2048 + k * 1024); } while (0)
#define PG8_MMA(ai, bj, At, Bt) do { __builtin_amdgcn_s_setprio(1); _Pragma("unroll") for (int m = 0; m < 4; ++m) _Pragma("unroll") for (int n = 0; n < 2; ++n) _Pragma("unroll") for (int k = 0; k < 2; ++k) \
        acc[ai][bj][m][n] = __builtin_amdgcn_mfma_f32_16x16x32_bf16(Bt[n][k], At[m][k], acc[ai][bj][m][n], 0, 0, 0); __builtin_amdgcn_s_setprio(0); } while (0)
#define PG8_WAIT_V(n) asm volatile("s_waitcnt vmcnt(" #n ")" ::: "memory")
#define PG8_WAIT_L(n) asm volatile("s_waitcnt lgkmcnt(" #n ")" ::: "memory")
#define PG8_BAR __builtin_amdgcn_s_barrier()
#define PG8_SCHED __builtin_amdgcn_sched_barrier(0)
    Unit cur, nxt; int ui = 0;
    if (!S.next(0, cur)) return;
    f32x4 acc[2][2][4][2];
#pragma unroll
    for (int a = 0; a < 2; ++a)
#pragma unroll
        for (int b = 0; b < 2; ++b)
#pragma unroll
            for (int m = 0; m < 4; ++m)
#pragma unroll
                for (int n = 0; n < 2; ++n) acc[a][b][m][n] = (f32x4){0.f, 0.f, 0.f, 0.f};
    bf16x8 At[4][2], B0[2][2], B1[2][2];
    const char* cA = (const char*)g.A + (size_t)cur.pm * tstepA; const char* cB = (const char*)g.Bt + (size_t)cur.pb * tstepB;
    PG8_STAGE(PG8_SB(0, 0), cB, voffB); PG8_STAGE(PG8_SB(0, 1), cB + hstepB, voffB); PG8_STAGE(PG8_SA(0, 0), cA, voffA); PG8_STAGE(PG8_SA(0, 1), cA + hstepA, voffA);
    if (wr == 1) PG8_BAR;
    PG8_WAIT_V(2); PG8_BAR;
    PG8_STAGE(PG8_SB(1, 0), cB + kstep, voffB); PG8_STAGE(PG8_SA(1, 0), cA + kstep, voffA); PG8_STAGE(PG8_SB(1, 1), cB + hstepB + kstep, voffB);
    PG8_WAIT_V(6); PG8_BAR;
    for (;;) {
        const bool has_next = S.next(ui + 1, nxt);
        const char* nA = has_next ? (const char*)g.A + (size_t)nxt.pm * tstepA : cA; const char* nB = has_next ? (const char*)g.Bt + (size_t)nxt.pb * tstepB : cB;
        for (int t = 0; t < nt; t += 2) {
            const bool last = (t == nt - 2);
            const char* a1 = cA + (size_t)(t + 1) * kstep;
            const char* a2 = last ? nA : cA + (size_t)(t + 2) * kstep; const char* b2 = last ? nB : cB + (size_t)(t + 2) * kstep;
            const char* a3 = a2 + kstep; const char* b3 = b2 + kstep;
            PG8_LDB(B0, 0, 0); PG8_LDB(B1, 0, 1); PG8_SCHED; PG8_LDA(At, 0, 0); PG8_STAGE(PG8_SA(1, 1), a1 + hstepA, voffA);
            PG8_WAIT_V(8); PG8_WAIT_L(0); PG8_BAR; PG8_MMA(0, 0, At, B0); PG8_MMA(0, 1, At, B1); PG8_BAR; PG8_SCHED;
            PG8_LDA(At, 0, 1); PG8_STAGE(PG8_SB(0, 0), b2, voffB); PG8_STAGE(PG8_SB(0, 1), b2 + hstepB, voffB); PG8_STAGE(PG8_SA(0, 0), a2, voffA);
            PG8_WAIT_V(8); PG8_WAIT_L(0); PG8_BAR; PG8_MMA(1, 0, At, B0); PG8_MMA(1, 1, At, B1); PG8_BAR; PG8_SCHED;
            PG8_LDB(B0, 1, 0); PG8_LDB(B1, 1, 1); PG8_SCHED; PG8_LDA(At, 1, 0); PG8_STAGE(PG8_SA(0, 1), a2 + hstepA, voffA);
            PG8_WAIT_V(8); PG8_WAIT_L(0); PG8_BAR; PG8_MMA(0, 0, At, B0); PG8_MMA(0, 1, At, B1); PG8_BAR; PG8_SCHED;
            PG8_LDA(At, 1, 1); PG8_STAGE(PG8_SB(1, 0), b3, voffB); PG8_STAGE(PG8_SB(1, 1), b3 + hstepB, voffB); PG8_STAGE(PG8_SA(1, 0), a3, voffA);
            PG8_WAIT_V(8); PG8_WAIT_L(0); PG8_BAR; PG8_MMA(1, 0, At, B0); PG8_MMA(1, 1, At, B1); PG8_BAR; PG8_SCHED;
        }
        if constexpr (ALIGN_EPI) { if (wr == 0) PG8_BAR; }
        E(acc, cur, wr, wc, fr, fq);
        if (!has_next) break;
#pragma unroll
        for (int a = 0; a < 2; ++a)
#pragma unroll
            for (int b = 0; b < 2; ++b)
#pragma unroll
                for (int m = 0; m < 4; ++m)
#pragma unroll
                    for (int n = 0; n < 2; ++n) acc[a][b][m][n] = (f32x4){0.f, 0.f, 0.f, 0.f};
        cur = nxt; cA = nA; cB = nB; ++ui;
        if constexpr (ALIGN_EPI) { if (wr == 1) PG8_BAR; }
    }
    PG8_WAIT_V(0);
    if constexpr (!ALIGN_EPI) { if (wr == 0) PG8_BAR; }
    PG8_BAR;
#undef PG8_SA
#undef PG8_SB
#undef PG8_STAGE
#undef PG8_LDA
#undef PG8_LDB
#undef PG8_MMA
#undef PG8_WAIT_V
#undef PG8_WAIT_L
#undef PG8_BAR
#undef PG8_SCHED
}
}

constexpr int NWAVES = 8;
constexpr int BATCH = 32, SEQ = 2048, DM = 1024, T = BATCH * SEQ, DIN = 6656;
constexpr int NE = 16, CAP = 256, DFF = 2048;
constexpr int OQ = 0, OK_ = 1024, OV = 1280, OCB = 1536, OCC = 2560, OCX = 3584, OGA = 4608, OGC = 5632;
constexpr int NCHUNK = 2, CBATCH = BATCH / NCHUNK, TC = CBATCH * SEQ;
constexpr int NEC = 2, EC = NE / NEC, MC = EC * BATCH * CAP;
constexpr float LN_EPS = 1e-5f, ALPHA = 1.189207115002721f, LOG2E = 1.4426950408889634f;
constexpr float QSCALE = 0.125f * LOG2E;

constexpr size_t MiB = 1u << 20;
constexpr size_t WS_CTL = 0, CTL_ZERO_BYTES = 64 * 1024;
constexpr size_t WS_STATS0 = 1 * MiB;
constexpr size_t WS_STATS1 = WS_STATS0 + 512 * 1024;
constexpr size_t WS_TOKIDX = 2 * MiB;
constexpr size_t WS_TOPVAL = WS_TOKIDX + 512 * 1024;
constexpr size_t WS_INV = 3 * MiB;
constexpr size_t WS_AFF = 5 * MiB;
constexpr size_t WS_WIN = 9 * MiB;
constexpr size_t WS_WAC = 22 * MiB;
constexpr size_t WS_WOUT = 26 * MiB;
constexpr size_t WS_WGU = 32 * MiB;
constexpr size_t WS_WDN = 160 * MiB;
constexpr size_t WS_XN = 224 * MiB;
constexpr size_t WS_MIX = 352 * MiB;
constexpr size_t WS_PROJ = WS_MIX;
constexpr size_t WS_AC = WS_PROJ + 416 * MiB;
constexpr size_t WS_TMP = WS_AC + 128 * MiB;
constexpr size_t WS_XE = WS_MIX;
constexpr size_t WS_H = WS_XE + 256 * MiB;
constexpr size_t WS_END = 960 * MiB;
static_assert(WS_TMP + (size_t)TC * DM * 2 <= WS_END && WS_H + (size_t)MC * DFF * 2 <= WS_END, "ws map");
static_assert(WS_PROJ + (size_t)TC * DIN * 2 <= WS_AC && WS_XN + (size_t)T * DM * 2 <= WS_MIX && WS_WDN + (size_t)NE * DM * DFF * 2 <= WS_XN, "ws map");

constexpr int CW_BAR = 4096;
constexpr int RING_BYTES = 131072, MISC_OFF = RING_BYTES + 320, LDS_BYTES = 147456;

#define GAS __attribute__((address_space(1)))
#define LAS __attribute__((address_space(3)))
typedef unsigned short bf16;
typedef unsigned v4u __attribute__((ext_vector_type(4)));
typedef unsigned v2u __attribute__((ext_vector_type(2)));
typedef float f32x4 __attribute__((ext_vector_type(4)));
typedef float f32x2 __attribute__((ext_vector_type(2)));
typedef float f32x16 __attribute__((ext_vector_type(16)));
typedef short bf16x8 __attribute__((ext_vector_type(8)));
typedef short s16x4 __attribute__((ext_vector_type(4)));
#define LDS_WAIT() asm volatile("s_waitcnt lgkmcnt(0)" ::: "memory")
__device__ __forceinline__ unsigned f2bf(float f) { unsigned u = __builtin_bit_cast(unsigned, f); return (u + 0x7fffu + ((u >> 16) & 1u)) >> 16; }
__device__ __forceinline__ unsigned pk2(float lo, float hi) { return f2bf(lo) | (f2bf(hi) << 16); }
__device__ __forceinline__ float bflo(unsigned u) { return __uint_as_float(u << 16); }
__device__ __forceinline__ float bfhi(unsigned u) { return __uint_as_float(u & 0xffff0000u); }
__device__ __forceinline__ float sigmoidf_(float x) { return __builtin_amdgcn_rcpf(1.0f + __expf(-x)); }

#define XB_TMO      128
#define XB_XCNT(j)  (256  + 64 * (j))
#define XB_XSUB(j)  (1280 + 64 * (j))
#define XB_XGEN(j)  (2304 + 64 * (j))
#define XB_TOP      3328
#define XB_TOPGEN   3392
#define XCD_BAR_WORDS 3456
#define XB_SPIN_CAP (1u << 22)
__device__ __forceinline__ unsigned xb_ld(unsigned* p)              { return __hip_atomic_load(p, __ATOMIC_RELAXED, __HIP_MEMORY_SCOPE_AGENT); }
__device__ __forceinline__ unsigned xb_add(unsigned* p, unsigned v) { return __hip_atomic_fetch_add(p, v, __ATOMIC_RELAXED, __HIP_MEMORY_SCOPE_AGENT); }
__device__ __forceinline__ unsigned xb_xcc_id() { return (unsigned)__builtin_amdgcn_s_getreg((3 << 11) | 20) & 0xFu; }
#define XB_SPIN(cond, bar) do { unsigned _sp = 0; while (cond) { __builtin_amdgcn_s_sleep(1); \
    if ((++_sp & 255u) == 0u) { if (xb_ld(&(bar)[XB_TMO])) break; if (_sp > XB_SPIN_CAP) { atomicAdd(&(bar)[XB_TMO], 1u); break; } } } } while (0)
struct XcdBarrier { unsigned* bar; unsigned x; volatile LAS unsigned* st; };
__device__ __forceinline__ XcdBarrier xcd_barrier_post(unsigned* bar, volatile LAS unsigned* st) {
    XcdBarrier b; b.bar = bar; b.x = xb_xcc_id(); b.st = st;
    if (threadIdx.x == 0) (void)xb_add(&bar[XB_XCNT(b.x)], 1u);
    return b;
}
__device__ __forceinline__ void xcd_barrier_complete(unsigned* bar, unsigned x, unsigned& nloc, unsigned& nx) {
    const unsigned G = gridDim.x * gridDim.y * gridDim.z;
    unsigned sum, cnt, mine, sp = 0u;
    for (;;) {
        sum = 0u; cnt = 0u; mine = 0u;
#pragma unroll
        for (unsigned j = 0; j < 16; ++j) { const unsigned c = xb_ld(&bar[XB_XCNT(j)]); sum += c; cnt += (c > 0u) ? 1u : 0u; mine = (j == x) ? c : mine; }
        if (sum == G) break;
        __builtin_amdgcn_s_sleep(1);
        if ((++sp & 255u) == 0u) { if (xb_ld(&bar[XB_TMO])) break; if (sp > XB_SPIN_CAP) { atomicAdd(&bar[XB_TMO], 1u); break; } }
    }
    nloc = mine > 0u ? mine : 1u; nx = cnt > 0u ? cnt : 1u;
}
__device__ __forceinline__ void xcd_barrier(const XcdBarrier& b) {
    asm volatile("s_waitcnt vmcnt(0)" ::: "memory");
    __syncthreads();
    if (threadIdx.x == 0) {
        unsigned* bar = b.bar;
        __builtin_amdgcn_s_waitcnt(0);
        unsigned nloc = b.st[0], nx = b.st[1];
        if (nloc == 0u) { xcd_barrier_complete(bar, b.x, nloc, nx); b.st[0] = nloc; b.st[1] = nx; }
        const unsigned old = xb_add(&bar[XB_XSUB(b.x)], 1u);
        const unsigned gen = old / nloc;
        if (old + 1u == (gen + 1u) * nloc) {
            __builtin_amdgcn_fence(__ATOMIC_RELEASE, "agent");
            asm volatile("s_waitcnt vmcnt(0)" ::: "memory");
            const unsigned og = xb_add(&bar[XB_TOP], 1u);
            const unsigned tg = og / nx;
            if (og + 1u == (tg + 1u) * nx) xb_add(&bar[XB_TOPGEN], 1u);
            else XB_SPIN(xb_ld(&bar[XB_TOPGEN]) == tg, bar);
            __builtin_amdgcn_fence(__ATOMIC_ACQUIRE, "agent");
            xb_add(&bar[XB_XGEN(b.x)], 1u);
            asm volatile("s_waitcnt vmcnt(0)" ::: "memory");
        } else {
            XB_SPIN(xb_ld(&bar[XB_XGEN(b.x)]) == gen, bar);
            __builtin_amdgcn_fence(__ATOMIC_ACQUIRE, "agent");
            asm volatile("s_waitcnt vmcnt(0)" ::: "memory");
        }
    }
    __syncthreads();
}

__device__ __forceinline__ float wave_sum(float v) {
#pragma unroll
    for (int o = 1; o < 64; o <<= 1) v += __shfl_xor(v, o);
    return v;
}

using pg8::Unit; using pg8::bf16_t;
struct EpiProj {
    static constexpr bool PERM = true;
    bf16* O;
    __device__ __forceinline__ void operator()(const f32x4 (&acc)[2][2][4][2], const Unit& u, int wr, int wc, int fr, int fq) const {
        const int row0 = u.pm * 256 + wr * 64 + fr, col0 = u.pn * 256 + wc * 32 + 8 * fq; const float sc = (u.pn < 4) ? QSCALE : 1.f;
#pragma unroll
        for (int ai = 0; ai < 2; ++ai)
#pragma unroll
            for (int m = 0; m < 4; ++m) { bf16* rowp = O + (size_t)(row0 + ai * 128 + m * 16) * DIN + col0;
#pragma unroll
                for (int bj = 0; bj < 2; ++bj) { const f32x4 v0 = acc[ai][bj][m][0] * sc, v1 = acc[ai][bj][m][1] * sc; v4u w;
                    w.x = pg8::cvt_pk_bf16(v0[0], v0[1]); w.y = pg8::cvt_pk_bf16(v0[2], v0[3]); w.z = pg8::cvt_pk_bf16(v1[0], v1[1]); w.w = pg8::cvt_pk_bf16(v1[2], v1[3]);
                    *(v4u*)(rowp + bj * 128) = w; } }
    }
};
template <int MODE> struct EpiGate {
    static constexpr bool PERM = true;
    const bf16* proj; bf16* tmp; int gcol0;
    __device__ __forceinline__ void operator()(const f32x4 (&acc)[2][2][4][2], const Unit& u, int wr, int wc, int fr, int fq) const {
        const int row0 = u.pm * 256 + wr * 64 + fr, col0 = u.pn * 256 + wc * 32 + 8 * fq;
#pragma unroll
        for (int ai = 0; ai < 2; ++ai)
#pragma unroll
            for (int m = 0; m < 4; ++m) { const size_t row = (size_t)(row0 + ai * 128 + m * 16);
#pragma unroll
                for (int bj = 0; bj < 2; ++bj) { const int col = col0 + bj * 128;
                    const v4u gv = *(const v4u*)(proj + row * DIN + gcol0 + col);
                    const f32x4 a0 = acc[ai][bj][m][0], a1 = acc[ai][bj][m][1];
                    float r[8];
                    r[0] = sigmoidf_(bflo(gv.x)) * a0[0]; r[1] = sigmoidf_(bfhi(gv.x)) * a0[1]; r[2] = sigmoidf_(bflo(gv.y)) * a0[2]; r[3] = sigmoidf_(bfhi(gv.y)) * a0[3];
                    r[4] = sigmoidf_(bflo(gv.z)) * a1[0]; r[5] = sigmoidf_(bfhi(gv.z)) * a1[1]; r[6] = sigmoidf_(bflo(gv.w)) * a1[2]; r[7] = sigmoidf_(bfhi(gv.w)) * a1[3];
                    bf16* op = tmp + row * DM + col;
                    if (MODE == 1) { const v4u tv = *(const v4u*)op;
                        r[0] += bflo(tv.x); r[1] += bfhi(tv.x); r[2] += bflo(tv.y); r[3] += bfhi(tv.y); r[4] += bflo(tv.z); r[5] += bfhi(tv.z); r[6] += bflo(tv.w); r[7] += bfhi(tv.w); }
                    v4u w; w.x = pg8::cvt_pk_bf16(r[0], r[1]); w.y = pg8::cvt_pk_bf16(r[2], r[3]); w.z = pg8::cvt_pk_bf16(r[4], r[5]); w.w = pg8::cvt_pk_bf16(r[6], r[7]);
                    *(v4u*)op = w; } }
    }
};
struct EpiResid {
    static constexpr bool PERM = false;
    const float* x; const float* stats0; const float* g0; const float* b0; float* out; int row_off;
    __device__ __forceinline__ void operator()(const f32x4 (&acc)[2][2][4][2], const Unit& u, int wr, int wc, int fr, int fq) const {
        const int row0 = row_off + u.pm * 256 + wr * 64 + fr, col0 = u.pn * 256 + wc * 32 + 4 * fq;
        f32x2 st[2][4];
#pragma unroll
        for (int ai = 0; ai < 2; ++ai)
#pragma unroll
            for (int m = 0; m < 4; ++m) st[ai][m] = *(const f32x2*)(stats0 + (size_t)(row0 + ai * 128 + m * 16) * 2);
#pragma unroll
        for (int bj = 0; bj < 2; ++bj)
#pragma unroll
            for (int n = 0; n < 2; ++n) { const int col = col0 + bj * 128 + n * 16; const f32x4 gv = *(const f32x4*)(g0 + col), bv = *(const f32x4*)(b0 + col);
#pragma unroll
                for (int ai = 0; ai < 2; ++ai)
#pragma unroll
                    for (int m = 0; m < 4; ++m) { const size_t off = (size_t)(row0 + ai * 128 + m * 16) * DM + col;
                        const f32x4 xv = *(const f32x4*)(x + off);
                        const f32x4 xn = (xv - st[ai][m].x) * st[ai][m].y * gv + bv;
                        *(f32x4*)(out + off) = xn * ALPHA + acc[ai][bj][m][n]; } }
    }
};
struct EpiSwiglu {
    static constexpr bool PERM = true;
    bf16* H;
    __device__ __forceinline__ void operator()(const f32x4 (&acc)[2][2][4][2], const Unit& u, int wr, int wc, int fr, int fq) const {
        const int row0 = u.pm * 256 + wr * 64 + fr, col0 = u.pn * 128 + wc * 32 + 8 * fq;
#pragma unroll
        for (int ai = 0; ai < 2; ++ai)
#pragma unroll
            for (int m = 0; m < 4; ++m) { float r[8];
#pragma unroll
                for (int n = 0; n < 2; ++n)
#pragma unroll
                    for (int j = 0; j < 4; ++j) { const float gte = acc[ai][0][m][n][j], up = acc[ai][1][m][n][j]; r[n * 4 + j] = gte * sigmoidf_(gte) * up; }
                v4u w; w.x = pg8::cvt_pk_bf16(r[0], r[1]); w.y = pg8::cvt_pk_bf16(r[2], r[3]); w.z = pg8::cvt_pk_bf16(r[4], r[5]); w.w = pg8::cvt_pk_bf16(r[6], r[7]);
                *(v4u*)(H + (size_t)(row0 + ai * 128 + m * 16) * DFF + col0) = w; }
    }
};
struct EpiDown {
    static constexpr bool PERM = true;
    bf16* Y; const float* topval;
    __device__ __forceinline__ void operator()(const f32x4 (&acc)[2][2][4][2], const Unit& u, int wr, int wc, int fr, int fq) const {
        const int row0 = u.pm * 256 + wr * 64 + fr, col0 = u.pn * 256 + wc * 32 + 8 * fq;
#pragma unroll
        for (int ai = 0; ai < 2; ++ai)
#pragma unroll
            for (int m = 0; m < 4; ++m) { const int row = row0 + ai * 128 + m * 16; const float tv = topval[row]; bf16* rowp = Y + (size_t)row * DM + col0;
#pragma unroll
                for (int bj = 0; bj < 2; ++bj) { const f32x4 v0 = acc[ai][bj][m][0] * tv, v1 = acc[ai][bj][m][1] * tv; v4u w;
                    w.x = pg8::cvt_pk_bf16(v0[0], v0[1]); w.y = pg8::cvt_pk_bf16(v0[2], v0[3]); w.z = pg8::cvt_pk_bf16(v1[0], v1[1]); w.w = pg8::cvt_pk_bf16(v1[2], v1[3]);
                    *(v4u*)(rowp + bj * 128) = w; } }
    }
};

__device__ __forceinline__ void transpose_item(const float* __restrict__ Wblk, int N, bf16* dst, int ldo, LAS float* scr, int lane) {
#pragma unroll 8
    for (int i = 0; i < 32; ++i) { const int kk = 2 * i + (lane >> 5); scr[kk * 33 + (lane & 31)] = Wblk[(size_t)kk * N + (lane & 31)]; }
    LDS_WAIT(); asm volatile("" ::: "memory");
    const int c = lane & 7;
#pragma unroll
    for (int j = 0; j < 4; ++j) { const int n = (lane >> 3) + 8 * j; const LAS float* s = scr + (8 * c) * 33 + n;
        v4u o; o.x = pk2(s[0 * 33], s[1 * 33]); o.y = pk2(s[2 * 33], s[3 * 33]); o.z = pk2(s[4 * 33], s[5 * 33]); o.w = pk2(s[6 * 33], s[7 * 33]);
        *(v4u*)(dst + (size_t)n * ldo + 8 * c) = o; }
    LDS_WAIT(); asm volatile("" ::: "memory");
}

struct Args { const float* in[17]; float* out; unsigned char* ws; int lo, hi; };
#define CAS __attribute__((address_space(4)))
__device__ __forceinline__ const void* karg(int byte_off) {
    const CAS char* kp = (const CAS char*)__builtin_amdgcn_kernarg_segment_ptr(); asm volatile("" : "+s"(kp)); return *(const void* const CAS*)(kp + byte_off); }

__device__ __forceinline__ f32x16 mfma32(bf16x8 a, bf16x8 b, f32x16 c) { return __builtin_amdgcn_mfma_f32_32x32x16_bf16(a, b, c, 0, 0, 0); }
__device__ __forceinline__ s16x4 vtr(LAS unsigned char* p) { return __builtin_bit_cast(s16x4, __builtin_amdgcn_ds_read_tr16_b64_v4i16((LAS s16x4*)p)); }
__device__ __forceinline__ void attn_unit(LAS unsigned char* lds, const bf16* __restrict__ proj, bf16* __restrict__ ac, const float* __restrict__ sink,
                                          int bl, int n, int g, int tid, int lane, int wave) {
    const int s_base = n * 128 - 128;
#pragma unroll
    for (int i = 0; i < 6; ++i) {
        const int p = tid + 512 * i, row = p >> 3, ch = p & 7, s = s_base + row;
        v4u kv = (v4u){0u, 0u, 0u, 0u}, vv = (v4u){0u, 0u, 0u, 0u};
        if (s >= 0 && s < SEQ) { const bf16* src = proj + (size_t)(bl * SEQ + s) * DIN + OK_ + g * 64 + ch * 8; kv = *(const v4u*)src; vv = *(const v4u*)(src + (OV - OK_)); }
        *(LAS v4u*)(lds + row * 128 + ((ch ^ ((row >> 1) & 7)) << 4)) = kv;
        *(LAS v4u*)(lds + 49152 + row * 128 + ((ch ^ (((row >> 1) & 1) << 2)) << 4)) = vv;
    }
    __syncthreads();
    const int ql = lane & 31, h5 = lane >> 5, rb = wave & 3, hp = wave >> 2;
    const int tq = n * 128 + rb * 32 + ql;
    const bf16* qrow = proj + (size_t)(bl * SEQ + tq) * DIN;
    bf16x8 qf[2][4];
    f32x16 o[2][2];
    float m_[2], l_[2], slope2[2];
#pragma unroll
    for (int hh = 0; hh < 2; ++hh) {
        const int head = 4 * g + 2 * hp + hh;
#pragma unroll
        for (int ks = 0; ks < 4; ++ks) qf[hh][ks] = *(const bf16x8*)(qrow + head * 64 + 16 * ks + 8 * h5);
#pragma unroll
        for (int r = 0; r < 16; ++r) { o[hh][0][r] = 0.f; o[hh][1][r] = 0.f; }
        m_[hh] = sink[head] * LOG2E; l_[hh] = (h5 == 0) ? 1.f : 0.f;
        slope2[hh] = exp2f(-0.5f * (float)(head + 1)) * LOG2E;
    }
    const int sw = (ql >> 1) & 7;
    int koff[4];
#pragma unroll
    for (int ks = 0; ks < 4; ++ks) koff[ks] = ql * 128 + (((2 * ks + h5) ^ sw) << 4);
    const int i16 = lane & 15, g16 = (lane >> 4) & 1, bsw = (lane >> 3) & 1;
    const int vb0 = 49152 + (4 * h5 + (i16 >> 2)) * 128 + ((((2 * g16) + ((i16 & 3) >> 1)) ^ (4 * bsw)) << 4) + (i16 & 1) * 8;
    const int vb1 = vb0 ^ 64;
#pragma unroll 1
    for (int d = 0; d < 9; ++d) {
        const int kb = rb + d;
        if ((n == 0 && kb < 4) || (n == SEQ / 128 - 1 && kb >= 8)) continue;
        bf16x8 kf[4], vf[2][2];
#pragma unroll
        for (int ks = 0; ks < 4; ++ks) kf[ks] = *(const LAS bf16x8*)(lds + kb * 4096 + koff[ks]);
#pragma unroll
        for (int s = 0; s < 2; ++s) {
            const s16x4 a0 = vtr(lds + vb0 + kb * 4096 + s * 2048), a1 = vtr(lds + vb0 + kb * 4096 + s * 2048 + 1024);
            const s16x4 c0 = vtr(lds + vb1 + kb * 4096 + s * 2048), c1 = vtr(lds + vb1 + kb * 4096 + s * 2048 + 1024);
            vf[0][s] = __builtin_shufflevector(a0, a1, 0, 1, 2, 3, 4, 5, 6, 7);
            vf[1][s] = __builtin_shufflevector(c0, c1, 0, 1, 2, 3, 4, 5, 6, 7);
        }
        const float basef = (float)(128 - 32 * d + ql - 4 * h5);
        const bool edge = (d == 0) || (d == 8);
#pragma unroll
        for (int hh = 0; hh < 2; ++hh) {
            f32x16 S;
#pragma unroll
            for (int r = 0; r < 16; ++r) S[r] = 0.f;
#pragma unroll
            for (int ks = 0; ks < 4; ++ks) S = mfma32(kf[ks], qf[hh][ks], S);
            float mb = -INFINITY;
#pragma unroll
            for (int r = 0; r < 16; ++r) {
                const float dist = fabsf(basef - (float)((r & 3) + 8 * (r >> 2)));
                float sv = S[r] - slope2[hh] * dist;
                if (edge && dist > 128.f) sv = -INFINITY;
                S[r] = sv; mb = fmaxf(mb, sv);
            }
            mb = fmaxf(mb, __shfl_xor(mb, 32));
            const float mn = fmaxf(m_[hh], mb), alpha = __builtin_amdgcn_exp2f(m_[hh] - mn);
            m_[hh] = mn;
            float ls = 0.f;
#pragma unroll
            for (int r = 0; r < 16; ++r) { const float p = __builtin_amdgcn_exp2f(S[r] - mn); S[r] = p; ls += p; }
            l_[hh] = l_[hh] * alpha + ls;
#pragma unroll
            for (int r = 0; r < 16; ++r) { o[hh][0][r] *= alpha; o[hh][1][r] *= alpha; }
            bf16x8 pf[2];
#pragma unroll
            for (int s = 0; s < 2; ++s) { v4u w; w.x = pg8::cvt_pk_bf16(S[8 * s + 0], S[8 * s + 1]); w.y = pg8::cvt_pk_bf16(S[8 * s + 2], S[8 * s + 3]);
                w.z = pg8::cvt_pk_bf16(S[8 * s + 4], S[8 * s + 5]); w.w = pg8::cvt_pk_bf16(S[8 * s + 6], S[8 * s + 7]); pf[s] = __builtin_bit_cast(bf16x8, w); }
#pragma unroll
            for (int tl = 0; tl < 2; ++tl)
#pragma unroll
                for (int s = 0; s < 2; ++s) o[hh][tl] = mfma32(vf[tl][s], pf[s], o[hh][tl]);
        }
    }
#pragma unroll
    for (int hh = 0; hh < 2; ++hh) {
        const int head = 4 * g + 2 * hp + hh;
        const float lt = l_[hh] + __shfl_xor(l_[hh], 32), inv = 1.0f / lt;
        bf16* orow = ac + (size_t)(bl * SEQ + tq) * (2 * DM) + head * 64 + 4 * h5;
#pragma unroll
        for (int tl = 0; tl < 2; ++tl)
#pragma unroll
            for (int rr = 0; rr < 4; ++rr) { v2u w; w.x = pg8::cvt_pk_bf16(o[hh][tl][4 * rr] * inv, o[hh][tl][4 * rr + 1] * inv); w.y = pg8::cvt_pk_bf16(o[hh][tl][4 * rr + 2] * inv, o[hh][tl][4 * rr + 3] * inv);
                *(v2u*)(orow + 32 * tl + 8 * rr) = w; }
    }
    __syncthreads();
}

__global__ void __launch_bounds__(NWAVES * 64, 2) hybrid_fwd(Args args) {
    extern __shared__ __attribute__((aligned(16))) unsigned char lds_raw[];
    LAS unsigned char* lds = (LAS unsigned char*)lds_raw;
    volatile LAS unsigned* MISC = (volatile LAS unsigned*)(lds + MISC_OFF);
    const int G = gridDim.x; const int bx = blockIdx.x; const int vcu = (G % 8 == 0) ? (bx % 8) * (G / 8) + bx / 8 : bx; const int NGW = G * NWAVES;
#define KARG(T_, off) ((T_)karg(off))
#define IN_(i) KARG(const float*, 8 * (i))
#define OUT_() KARG(float*, 136)
#define WSP(T_, off) ((T_)((unsigned char*)karg(144) + (off)))

    for (int u = threadIdx.x; u < (LDS_BYTES - RING_BYTES) / 4; u += NWAVES * 64) ((LAS unsigned*)(lds + RING_BYTES))[u] = 0u;
    __syncthreads();
    const int lo = args.lo, hi = args.hi;
    XcdBarrier bar; bar.bar = WSP(unsigned*, WS_CTL) + CW_BAR; bar.x = 0; bar.st = nullptr;
    if (hi - lo > 1) bar = xcd_barrier_post(WSP(unsigned*, WS_CTL) + CW_BAR, MISC + 8);
    int s = 0;
#define STEP_BEGIN if (lo <= s && s < hi) { int tid_ = threadIdx.x; asm volatile("" : "+v"(tid_)); const int tid = tid_, lane = tid & 63, wave = __builtin_amdgcn_readfirstlane(tid >> 6), gw = vcu * NWAVES + wave; (void)lane; (void)gw;
#define STEP_END   if (s + 1 < hi) xcd_barrier(bar); } ++s;

    STEP_BEGIN
    {
        LAS float* scr = (LAS float*)(lds + wave * 16384);
        constexpr int I_IN = (DM / 64) * (DIN / 32), I_SQ = (DM / 64) * (DM / 32), I_GU = (DM / 64) * (DFF / 32), I_DN = (DFF / 64) * (DM / 32);
        constexpr int NITEMS = I_IN + 3 * I_SQ + NE * (2 * I_GU + I_DN);
        for (int it = gw; it < NITEMS; it += NGW) {
            int r = it;
            if (r < I_IN) { const int nblk = DIN / 32, kb = r / nblk, nb = r % nblk; transpose_item(IN_(3) + (size_t)(64 * kb) * DIN + 32 * nb, DIN, WSP(bf16*, WS_WIN) + (size_t)(32 * nb) * DM + 64 * kb, DM, scr, lane); continue; } r -= I_IN;
            if (r < 3 * I_SQ) { const int which = r / I_SQ, q = r % I_SQ, nblk = DM / 32, kb = q / nblk, nb = q % nblk;
                const float* W = which == 0 ? IN_(6) : (which == 1 ? IN_(7) : IN_(8));
                bf16* dst = which == 2 ? WSP(bf16*, WS_WOUT) + (size_t)(32 * nb) * DM + 64 * kb : WSP(bf16*, WS_WAC) + (size_t)(32 * nb) * (2 * DM) + which * DM + 64 * kb;
                transpose_item(W + (size_t)(64 * kb) * DM + 32 * nb, DM, dst, which == 2 ? DM : 2 * DM, scr, lane); continue; } r -= 3 * I_SQ;
            const int e = r / (2 * I_GU + I_DN); r -= e * (2 * I_GU + I_DN);
            if (r < 2 * I_GU) { const int which = r / I_GU, q = r % I_GU, nblk = DFF / 32, kb = q / nblk, nb = q % nblk, n0 = 32 * nb;
                const float* W = (which == 0 ? IN_(12) : IN_(13)) + (size_t)e * DM * DFF;
                const int orow = (n0 >> 7) * 256 + which * 128 + (n0 & 127);
                transpose_item(W + (size_t)(64 * kb) * DFF + n0, DFF, WSP(bf16*, WS_WGU) + ((size_t)e * (2 * DFF) + orow) * DM + 64 * kb, DM, scr, lane); continue; } r -= 2 * I_GU;
            { const int nblk = DM / 32, kb = r / nblk, nb = r % nblk;
                transpose_item(IN_(14) + (size_t)e * DFF * DM + (size_t)(64 * kb) * DM + 32 * nb, DM, WSP(bf16*, WS_WDN) + ((size_t)e * DM + 32 * nb) * DFF + 64 * kb, DFF, scr, lane); }
        }
        const float* x = IN_(0); const float* ln0_g = IN_(1); const float* ln0_b = IN_(2); float* stats0 = WSP(float*, WS_STATS0); bf16* XN = WSP(bf16*, WS_XN);
        f32x4 gv[4], bv[4];
#pragma unroll
        for (int j = 0; j < 4; ++j) { gv[j] = *(const f32x4*)(ln0_g + 4 * lane + 256 * j); bv[j] = *(const f32x4*)(ln0_b + 4 * lane + 256 * j); }
        for (int m = gw; m < T; m += NGW) {
            const f32x4* xr = (const f32x4*)(x + (size_t)m * DM) + lane;
            f32x4 v[4]; float sm = 0.f;
#pragma unroll
            for (int j = 0; j < 4; ++j) { v[j] = xr[64 * j]; sm += (v[j].x + v[j].y) + (v[j].z + v[j].w); }
            const float mean = wave_sum(sm) * (1.f / DM); float s2 = 0.f;
#pragma unroll
            for (int j = 0; j < 4; ++j) { v[j] = v[j] - mean; s2 += (v[j].x * v[j].x + v[j].y * v[j].y) + (v[j].z * v[j].z + v[j].w * v[j].w); }
            const float rstd = 1.f / sqrtf(wave_sum(s2) * (1.f / DM) + LN_EPS);
            if (lane == 0) *(f32x2*)(stats0 + (size_t)m * 2) = (f32x2){mean, rstd};
            v2u* o8 = (v2u*)(XN + (size_t)m * DM) + lane;
#pragma unroll
            for (int j = 0; j < 4; ++j) { const f32x4 y = v[j] * rstd * gv[j] + bv[j]; v2u w; w.x = pk2(y.x, y.y); w.y = pk2(y.z, y.w); o8[64 * j] = w; }
        }
    }
    STEP_END

#pragma unroll 1
    for (int c = 0; c < NCHUNK; ++c) {
        STEP_BEGIN
        {
            pg8::Gemm g{WSP(bf16*, WS_XN) + (size_t)c * TC * DM, WSP(bf16*, WS_WIN), DM, DM, DM}; pg8::StaticOrder S; S.init(TC, DIN, G, bx);
            EpiProj E{WSP(bf16*, WS_PROJ)};
            pg8::gemm_phase<EpiProj, pg8::StaticOrder, true>(lds, g, S, E);
        }
        STEP_END
        STEP_BEGIN
        {
            const bf16* PROJ = WSP(const bf16*, WS_PROJ); bf16* AC = WSP(bf16*, WS_AC);
            constexpr int NU = CBATCH * (SEQ / 128) * 4;
            { const float* attn_sink = IN_(5);
              for (int u = vcu; u < NU; u += G) attn_unit(lds, PROJ, AC, attn_sink, u >> 6, (u >> 2) & 15, u & 3, tid, lane, wave); }
            const int seg = tid >> 7, cg = tid & 127, ch = cg * 8;
            float w0[8], w1[8], w2[8];
            { const float* conv_w = IN_(4);
#pragma unroll
              for (int j = 0; j < 8; ++j) { w0[j] = conv_w[ch + j]; w1[j] = conv_w[DM + ch + j]; w2[j] = conv_w[2 * DM + ch + j]; } }
            for (int it = vcu; it < TC / 64; it += G) {
                const int t0 = it * 64 + seg * 16;
                const int sq0 = t0 & (SEQ - 1);
                float up[8], uc[8], un[8];
                auto load_u = [&](int trow, int spos, float (&uu)[8]) {
                    if (spos < 0 || spos >= SEQ) {
#pragma unroll
                        for (int j = 0; j < 8; ++j) uu[j] = 0.f; return; }
                    const bf16* p = PROJ + (size_t)trow * DIN + ch; const v4u a = *(const v4u*)(p + OCC), b = *(const v4u*)(p + OCX);
                    uu[0] = bflo(a.x) * bflo(b.x); uu[1] = bfhi(a.x) * bfhi(b.x); uu[2] = bflo(a.y) * bflo(b.y); uu[3] = bfhi(a.y) * bfhi(b.y);
                    uu[4] = bflo(a.z) * bflo(b.z); uu[5] = bfhi(a.z) * bfhi(b.z); uu[6] = bflo(a.w) * bflo(b.w); uu[7] = bfhi(a.w) * bfhi(b.w); };
                load_u(t0 - 1, sq0 - 1, up); load_u(t0, sq0, uc);
#pragma unroll 4
                for (int i = 0; i < 16; ++i) {
                    load_u(t0 + i + 1, sq0 + i + 1, un);
                    const v4u cbv = *(const v4u*)(PROJ + (size_t)(t0 + i) * DIN + OCB + ch);
                    float y[8];
#pragma unroll
                    for (int j = 0; j < 8; ++j) y[j] = w0[j] * up[j] + w1[j] * uc[j] + w2[j] * un[j];
                    y[0] *= bflo(cbv.x); y[1] *= bfhi(cbv.x); y[2] *= bflo(cbv.y); y[3] *= bfhi(cbv.y); y[4] *= bflo(cbv.z); y[5] *= bfhi(cbv.z); y[6] *= bflo(cbv.w); y[7] *= bfhi(cbv.w);
                    v4u w; w.x = pk2(y[0], y[1]); w.y = pk2(y[2], y[3]); w.z = pk2(y[4], y[5]); w.w = pk2(y[6], y[7]);
                    *(v4u*)(AC + (size_t)(t0 + i) * (2 * DM) + DM + ch) = w;
#pragma unroll
                    for (int j = 0; j < 8; ++j) { up[j] = uc[j]; uc[j] = un[j]; }
                }
            }
        }
        STEP_END
        STEP_BEGIN
        {
            { pg8::Gemm g{WSP(bf16*, WS_AC), WSP(bf16*, WS_WAC), 2 * DM, 2 * DM, DM}; pg8::StaticOrder S; S.init(TC, DM, G, bx);
              EpiGate<0> E{WSP(const bf16*, WS_PROJ), WSP(bf16*, WS_TMP), OGA};
              pg8::gemm_phase<EpiGate<0>, pg8::StaticOrder, true>(lds, g, S, E); }
            { pg8::Gemm g{WSP(bf16*, WS_AC) + DM, WSP(bf16*, WS_WAC) + DM, 2 * DM, 2 * DM, DM}; pg8::StaticOrder S; S.init(TC, DM, G, bx);
              EpiGate<1> E{WSP(const bf16*, WS_PROJ), WSP(bf16*, WS_TMP), OGC};
              pg8::gemm_phase<EpiGate<1>, pg8::StaticOrder, true>(lds, g, S, E); }
        }
        STEP_END
        STEP_BEGIN
        {
            pg8::Gemm g{WSP(bf16*, WS_TMP), WSP(bf16*, WS_WOUT), DM, DM, DM}; pg8::StaticOrder S; S.init(TC, DM, G, bx);
            EpiResid E{IN_(0), WSP(const float*, WS_STATS0), IN_(1), IN_(2), OUT_(), c * TC};
            pg8::gemm_phase<EpiResid, pg8::StaticOrder, true>(lds, g, S, E);
        }
        STEP_END
    }

    STEP_BEGIN
    {
        LAS float* wr_l = (LAS float*)lds;
        { const float* w_router = IN_(11);
          for (int i = tid; i < DM * NE; i += NWAVES * 64) { const int k = i >> 4, e = i & 15; wr_l[e * DM + k] = w_router[i]; } }
        __syncthreads();
        const float* ln1_g = IN_(9); const float* ln1_b = IN_(10); const float* yb = OUT_(); float* stats1 = WSP(float*, WS_STATS1); bf16* XN = WSP(bf16*, WS_XN); float* aff = WSP(float*, WS_AFF);
        f32x4 gv[4], bv[4];
#pragma unroll
        for (int j = 0; j < 4; ++j) { gv[j] = *(const f32x4*)(ln1_g + 4 * lane + 256 * j); bv[j] = *(const f32x4*)(ln1_b + 4 * lane + 256 * j); }
        for (int m = gw; m < T; m += NGW) {
            const f32x4* yr = (const f32x4*)(yb + (size_t)m * DM) + lane;
            f32x4 v[4]; float sm = 0.f;
#pragma unroll
            for (int j = 0; j < 4; ++j) { v[j] = yr[64 * j]; sm += (v[j].x + v[j].y) + (v[j].z + v[j].w); }
            const float mean = wave_sum(sm) * (1.f / DM); float s2 = 0.f;
#pragma unroll
            for (int j = 0; j < 4; ++j) { v[j] = v[j] - mean; s2 += (v[j].x * v[j].x + v[j].y * v[j].y) + (v[j].z * v[j].z + v[j].w * v[j].w); }
            const float rstd = 1.f / sqrtf(wave_sum(s2) * (1.f / DM) + LN_EPS);
            if (lane == 0) *(f32x2*)(stats1 + (size_t)m * 2) = (f32x2){mean, rstd};
            v2u* o8 = (v2u*)(XN + (size_t)m * DM) + lane;
#pragma unroll
            for (int j = 0; j < 4; ++j) { v[j] = v[j] * rstd * gv[j] + bv[j]; v2u w; w.x = pk2(v[j].x, v[j].y); w.y = pk2(v[j].z, v[j].w); o8[64 * j] = w; }
            float mine = 0.f;
#pragma unroll 2
            for (int e = 0; e < NE; ++e) { float a = 0.f;
#pragma unroll
                for (int j = 0; j < 4; ++j) { const f32x4 wv = *(const LAS f32x4*)(wr_l + e * DM + 4 * lane + 256 * j); a += (v[j].x * wv.x + v[j].y * wv.y) + (v[j].z * wv.z + v[j].w * wv.w); }
                const float tot = wave_sum(a); mine = (lane == e) ? tot : mine; }
            float mx = mine;
#pragma unroll
            for (int o = 1; o < 16; o <<= 1) mx = fmaxf(mx, __shfl_xor(mx, o));
            const float ex = expf(mine - mx); float den = ex;
#pragma unroll
            for (int o = 1; o < 16; o <<= 1) den += __shfl_xor(den, o);
            if (lane < NE) aff[(size_t)m * NE + lane] = ex / den;
        }
    }
    STEP_END

    STEP_BEGIN
    {
        if (wave < 2) {
            const float* aff = WSP(const float*, WS_AFF); int* tokidx = WSP(int*, WS_TOKIDX); float* topval = WSP(float*, WS_TOPVAL); short* inv = WSP(short*, WS_INV);
            for (int u = vcu * 2 + wave; u < BATCH * NE; u += G * 2) {
                const int b = u >> 4, e = u & 15;
                unsigned key[32];
#pragma unroll
                for (int i = 0; i < 32; ++i) key[i] = __float_as_uint(aff[(size_t)(b * SEQ + lane + 64 * i) * NE + e]);
                unsigned thr = 0u;
                for (int bit = 30; bit >= 0; --bit) {
                    const unsigned cand = thr | (1u << bit); int cnt = 0;
#pragma unroll
                    for (int i = 0; i < 32; ++i) cnt += __popcll(__ballot(key[i] >= cand));
                    if (cnt >= CAP) thr = cand;
                }
                int ngt = 0;
#pragma unroll
                for (int i = 0; i < 32; ++i) ngt += __popcll(__ballot(key[i] > thr));
                const int need = CAP - ngt;
                int selb = 0, tieb = 0;
                const unsigned long long below = (1ull << lane) - 1ull;
                const size_t sbase = ((size_t)e * BATCH + b) * CAP;
#pragma unroll
                for (int i = 0; i < 32; ++i) {
                    const bool gt = key[i] > thr, eq = key[i] == thr;
                    const unsigned long long beq = __ballot(eq);
                    const int trank = tieb + __popcll(beq & below);
                    const bool sel = gt || (eq && trank < need);
                    const unsigned long long bsel = __ballot(sel);
                    const int cpos = selb + __popcll(bsel & below);
                    const int t = lane + 64 * i;
                    if (sel) { tokidx[sbase + cpos] = t; topval[sbase + cpos] = __uint_as_float(key[i]); }
                    inv[(size_t)(b * SEQ + t) * NE + e] = sel ? (short)cpos : (short)-1;
                    selb += __popcll(bsel); tieb += __popcll(beq);
                }
            }
        }
    }
    STEP_END

    STEP_BEGIN
    {
        const int* tokidx = WSP(const int*, WS_TOKIDX); const bf16* XN = WSP(const bf16*, WS_XN); bf16* XE = WSP(bf16*, WS_XE);
        for (int r = gw; r < NE * BATCH * CAP; r += NGW) {
            const int b = (r >> 8) & (BATCH - 1); const int t = tokidx[r];
            const v4u* src = (const v4u*)(XN + (size_t)(b * SEQ + t) * DM) + lane; v4u* dst = (v4u*)(XE + (size_t)r * DM) + lane;
            const v4u a = src[0], c2 = src[64]; dst[0] = a; dst[64] = c2;
        }
    }
    STEP_END

#pragma unroll 1
    for (int ec = 0; ec < NEC; ++ec) {
        STEP_BEGIN
        {
            pg8::Gemm g{WSP(bf16*, WS_XE) + (size_t)ec * MC * DM, WSP(bf16*, WS_WGU), DM, DM, DM}; pg8::StaticOrder S; S.init(MC, 2 * DFF, G, bx, 5, ec * EC * (2 * DFF / 256));
            EpiSwiglu E{WSP(bf16*, WS_H)};
            pg8::gemm_phase<EpiSwiglu, pg8::StaticOrder, true>(lds, g, S, E);
        }
        STEP_END
        STEP_BEGIN
        {
            pg8::Gemm g{WSP(bf16*, WS_H), WSP(bf16*, WS_WDN), DFF, DFF, DFF}; pg8::StaticOrder S; S.init(MC, DM, G, bx, 5, ec * EC * (DM / 256));
            EpiDown E{WSP(bf16*, WS_XE) + (size_t)ec * MC * DM, WSP(const float*, WS_TOPVAL) + (size_t)ec * MC};
            pg8::gemm_phase<EpiDown, pg8::StaticOrder, true>(lds, g, S, E);
        }
        STEP_END
    }

    STEP_BEGIN
    {
        const float* ln1_g = IN_(9); const float* ln1_b = IN_(10); const float* ln2_g = IN_(15); const float* ln2_b = IN_(16);
        float* outp = OUT_(); const float* stats1 = WSP(const float*, WS_STATS1); const short* inv = WSP(const short*, WS_INV); const bf16* YE = WSP(const bf16*, WS_XE);
        f32x4 gv[4], bv[4], g2[4], b2[4];
#pragma unroll
        for (int j = 0; j < 4; ++j) { gv[j] = *(const f32x4*)(ln1_g + 4 * lane + 256 * j); bv[j] = *(const f32x4*)(ln1_b + 4 * lane + 256 * j);
            g2[j] = *(const f32x4*)(ln2_g + 4 * lane + 256 * j); b2[j] = *(const f32x4*)(ln2_b + 4 * lane + 256 * j); }
        for (int m = gw; m < T; m += NGW) {
            f32x4* yr = (f32x4*)(outp + (size_t)m * DM) + lane;
            const f32x2 st = *(const f32x2*)(stats1 + (size_t)m * 2);
            f32x4 v[4];
#pragma unroll
            for (int j = 0; j < 4; ++j) v[j] = ((yr[64 * j] - st.x) * st.y * gv[j] + bv[j]) * ALPHA;
            const int b = m >> 11;
            const int myslot = (lane < NE) ? (int)inv[(size_t)m * NE + lane] : -1;
#pragma unroll 1
            for (int e = 0; e < NE; ++e) {
                const int cpos = __builtin_amdgcn_readlane(myslot, e);
                if (cpos >= 0) {
                    const v2u* yp = (const v2u*)(YE + ((size_t)(e * BATCH + b) * CAP + cpos) * DM) + lane;
#pragma unroll
                    for (int j = 0; j < 4; ++j) { const v2u w = yp[64 * j]; v[j].x += bflo(w.x); v[j].y += bfhi(w.x); v[j].z += bflo(w.y); v[j].w += bfhi(w.y); }
                }
            }
            float sm = 0.f;
#pragma unroll
            for (int j = 0; j < 4; ++j) sm += (v[j].x + v[j].y) + (v[j].z + v[j].w);
            const float mean = wave_sum(sm) * (1.f / DM); float s2 = 0.f;
#pragma unroll
            for (int j = 0; j < 4; ++j) { v[j] = v[j] - mean; s2 += (v[j].x * v[j].x + v[j].y * v[j].y) + (v[j].z * v[j].z + v[j].w * v[j].w); }
            const float rstd = 1.f / sqrtf(wave_sum(s2) * (1.f / DM) + LN_EPS);
#pragma unroll
            for (int j = 0; j < 4; ++j) yr[64 * j] = v[j] * rstd * g2[j] + b2[j];
        }
    }
    STEP_END
#undef STEP_BEGIN
#undef STEP_END
}

constexpr int NSTEPS = 1 + NCHUNK * 4 + 3 + NEC * 2 + 1;

extern "C" void kernel_launch(void* const* d_in, const int* in_sizes, int n_in, void* d_out, int out_size, void* d_ws, size_t ws_size, hipStream_t stream) {
    static int grid = 0;
    if (grid == 0) {
        if (n_in != 17 || in_sizes[0] != T * DM || out_size != T * DM || ws_size < WS_END) { fprintf(stderr, "kernel_launch: unexpected shapes / workspace (%zu < %zu); nothing launched\n", ws_size, (size_t)WS_END); grid = -1; return; }
        int dev = 0, cus = 0, per_cu = 0;
        if (hipGetDevice(&dev) != hipSuccess || hipDeviceGetAttribute(&cus, hipDeviceAttributeMultiprocessorCount, dev) != hipSuccess) { grid = -1; return; }
        if (hipFuncSetAttribute((const void*)hybrid_fwd, hipFuncAttributeMaxDynamicSharedMemorySize, LDS_BYTES) != hipSuccess) { fprintf(stderr, "kernel_launch: hipFuncSetAttribute failed\n"); grid = -1; return; }
        if (hipOccupancyMaxActiveBlocksPerMultiprocessor(&per_cu, (const void*)hybrid_fwd, NWAVES * 64, LDS_BYTES) != hipSuccess || per_cu < 1)
            fprintf(stderr, "kernel_launch: occupancy query reports %d workgroups per CU\n", per_cu);
        (void)hipGetLastError();
        grid = cus;
    }
    if (grid < 0) return;
    (void)hipMemsetAsync((char*)d_ws + WS_CTL, 0, CTL_ZERO_BYTES, stream);
    Args a{};
    for (int i = 0; i < 17; ++i) a.in[i] = (const float*)d_in[i];
    a.out = (float*)d_out; a.ws = (unsigned char*)d_ws;
#if ONE_LAUNCH
    a.lo = 0; a.hi = NSTEPS;
    hipLaunchKernelGGL(hybrid_fwd, dim3(grid), dim3(NWAVES * 64), LDS_BYTES, stream, a);
#else
    for (int st = 0; st < NSTEPS; ++st) { a.lo = st; a.hi = st + 1; hipLaunchKernelGGL(hybrid_fwd, dim3(grid), dim3(NWAVES * 64), LDS_BYTES, stream, a); }
#endif
}
```

```cpp
#include <hip/hip_runtime.h>
#include <type_traits>
#include <cstdio>
#include <cstdint>

#ifndef REPEAT_MASK
#define REPEAT_MASK 0
#endif
#ifndef PROBE_KREP
#define PROBE_KREP 1
#endif
#ifndef PROBE_NOISE
#define PROBE_NOISE 0
#endif
#ifndef PROBE_EPIREP
#define PROBE_EPIREP 1
#endif
#ifndef PROBE_MFMA
#define PROBE_MFMA 0
#endif
#ifndef ONE_LAUNCH
#define ONE_LAUNCH 1
#endif

namespace pg8 {
#define PG8_LAS __attribute__((address_space(3)))
typedef unsigned short bf16_t;
typedef short bf16x8 __attribute__((ext_vector_type(8)));
typedef float f32x4 __attribute__((ext_vector_type(4)));
typedef unsigned u32x4 __attribute__((ext_vector_type(4)));
constexpr int BM = 256, BK = 64, HALF = 128, HTB = HALF * BK * 2  , STAGE_BYTES = 8 * HTB, NXCD = 8, WGM = 8;

__host__ __device__ __forceinline__ int lds_byte(int r, int c) { const int st = (r >> 4) * 2 + (c >> 5), rr = r & 15, cc = c & 31, ob = rr * 64 + cc * 2; return st * 1024 + (ob ^ (((ob >> 9) & 1) << 5)); }
__host__ __device__ __forceinline__ void stage_rc(int b, int& R, int& C) { const int st = b / 1024, sb = b % 1024, swz = sb ^ (((sb >> 9) & 1) << 5); R = (st >> 1) * 16 + swz / 64; C = (st & 1) * 32 + (swz % 64) / 2; }
__host__ __device__ __forceinline__ int perm32(int rho) { const int n = rho >> 4, i = rho & 15; return 8 * (i >> 2) + 4 * n + (i & 3); }

struct Unit { int pm, pn, pb; };
struct Gemm { const void* A; const void* Bt; int lda, ldb, nt; const int* gtok; int tab_off; };

struct StaticOrder {
    int nM, nN, nwg, G, c, gshift, pb0;
    __device__ void init(int M, int N, int G_, int c_, int gshift_ = 30, int pb0_ = 0) { nM = M / BM; nN = N / BM; nwg = nM * nN; G = G_; c = c_; gshift = gshift_; pb0 = pb0_; }
    __device__ bool next(int i, Unit& u) const {
        const long L = (long)i * G + c; if (L >= nwg) return false;
        int wgid = (int)L; { const int q = nwg / NXCD, r = nwg % NXCD, xcd = wgid % NXCD, off = wgid / NXCD; wgid = (xcd < r ? xcd * (q + 1) : r * (q + 1) + (xcd - r) * q) + off; }
        const int nig = WGM * nN, gid = wgid / nig, fm = gid * WGM, gsz = (nM - fm) < WGM ? (nM - fm) : WGM;
        u.pm = fm + ((wgid % nig) % gsz); u.pn = (wgid % nig) / gsz; u.pb = (u.pm >> gshift) * nN + pb0 + u.pn; return true;
    }
};

template <int NM, int NN, int GSHIFT = 30> struct StaticOrderT {
    int G, c;
    __device__ void init(int G_, int c_) { G = G_; c = c_; }
    __device__ bool next(int i, Unit& u) const {
        static_assert(NM % WGM == 0 && (NM * NN) % NXCD == 0, "StaticOrderT shapes");
        constexpr int nwg = NM * NN, q = nwg / NXCD, nig = WGM * NN;
        const int L = i * G + c; if (L >= nwg) return false;
        const int wgid = (L % NXCD) * q + L / NXCD, w = wgid % nig;
        u.pm = (wgid / nig) * WGM + (w % WGM); u.pn = w / WGM; u.pb = (u.pm >> GSHIFT) * NN + u.pn; return true;
    }
};

__device__ __forceinline__ unsigned cvt_pk_bf16(float lo, float hi) { unsigned r; asm volatile("v_cvt_pk_bf16_f32 %0, %1, %2" : "=v"(r) : "v"(lo), "v"(hi)); return r; }

typedef int v8i_t __attribute__((ext_vector_type(8))); typedef int v4i_t __attribute__((ext_vector_type(4)));
__device__ __forceinline__ v8i_t cat8(bf16x8 lo, bf16x8 hi) { return __builtin_shufflevector(__builtin_bit_cast(v4i_t, lo), __builtin_bit_cast(v4i_t, hi), 0, 1, 2, 3, 4, 5, 6, 7); }
template <class Epi, class Sched, bool ALIGN_EPI = false, bool FP8 = false, int KREP = 1, int EPIREP = 1, bool AG = false, bool AT = false>
__device__ __forceinline__ void gemm_phase(PG8_LAS unsigned char* lds, const Gemm g, const Sched& S, const Epi& E) {
    int tid_ = threadIdx.x; asm volatile("" : "+v"(tid_));
    const int tid = tid_, wid = __builtin_amdgcn_readfirstlane(tid >> 6), lane = tid & 63, wr = wid >> 2, wc = wid & 3, fr = lane & 15, fq = lane >> 4;
    const int nt = g.nt;
    unsigned voffA[2], voffB[2]; int rowA[2], colA[2];
#pragma unroll
    for (int i = 0; i < 2; ++i) { int R, C; stage_rc(tid * 16 + i * 8192, R, C); const int Rb = 64 * (R >> 5) + (Epi::PERM ? perm32(R & 31) : (R & 31));
        voffA[i] = AT ? (unsigned)((R >> 4) * 16 * g.lda + (R & 15) * 32 + ((C * 2) >> 5) * 512 + ((C * 2) & 31)) : (unsigned)(R * g.lda + C * 2); voffB[i] = (unsigned)(Rb * g.ldb + C * 2); rowA[i] = R; colA[i] = C * 2; }
    const __amdgpu_buffer_rsrc_t rsA = __builtin_amdgcn_make_buffer_rsrc((void*)g.A, 0, -1, 0x00020000), rsB = __builtin_amdgcn_make_buffer_rsrc((void*)g.Bt, 0, -1, 0x00020000);
    const unsigned kstep = (unsigned)(BK * 2), kstepA = AT ? 2048u : kstep;
    const unsigned hstepA = AG ? 0u : (unsigned)(HALF * g.lda), hstepB = (unsigned)(32 * g.ldb);
    const unsigned tstepA = 2u * hstepA, tstepB = (unsigned)(BM * g.ldb);
    const unsigned ldsw = (unsigned)wid * 1024u;
    const int aoff = lds_byte(wr * 64 + fr, fq * 8), boff = lds_byte(wc * 32 + fr, fq * 8);
#define PG8_SA(b, h) (((b) * 2 + (h)) * HTB)
#define PG8_SB(b, h) ((4 + (b) * 2 + (h)) * HTB)
#define PG8_STAGE(bufoff, rs, soff, voff) do { _Pragma("unroll") for (int _i = 0; _i < 2; ++_i) \
        __builtin_amdgcn_raw_ptr_buffer_load_lds(rs, (PG8_LAS unsigned*)(lds + (bufoff) + ldsw + _i * 8192), 16, (int)(voff)[_i], (int)(soff), 0, 0); } while (0)
#define PG8_LDF(base) cat8(*(const PG8_LAS bf16x8*)(lds + (base)), *(const PG8_LAS bf16x8*)(lds + (base) + 1024))
#define PG8_LDA(dst, b, h) do { _Pragma("unroll") for (int m = 0; m < 4; ++m) dst[m] = PG8_LDF(PG8_SA(b, h) + aoff + m * 2048); } while (0)
#define PG8_LDB(dst, b, h) do { _Pragma("unroll") for (int n = 0; n < 2; ++n) dst[n] = PG8_LDF(PG8_SB(b, h) + boff + n * 2048); } while (0)
#define PG8_LO(f) __builtin_bit_cast(bf16x8, __builtin_shufflevector(f, f, 0, 1, 2, 3))
#define PG8_HI(f) __builtin_bit_cast(bf16x8, __builtin_shufflevector(f, f, 4, 5, 6, 7))
#define PG8_MMA(ai, bj, At, Bt) do { __builtin_amdgcn_s_setprio(1);   \
        if constexpr (FP8) { _Pragma("unroll") for (int m = 0; m < 4; ++m) _Pragma("unroll") for (int n = 0; n < 2; ++n) \
            asm volatile("v_mfma_f32_16x16x128_f8f6f4 %0, %1, %2, %0" : "+v"(acc[ai][bj][m][n]) : "v"(Bt[n]), "v"(At[m])); } \
        else if constexpr (Epi::ASM_BF16) {   \
            _Pragma("unroll") for (int m = 0; m < 4; m += 2) { \
                _Pragma("unroll") for (int mm = m; mm < m + 2; ++mm) _Pragma("unroll") for (int n = 0; n < 2; ++n) \
                    asm volatile("v_mfma_f32_16x16x32_bf16 %0, %1, %2, %0" : "+v"(acc[ai][bj][mm][n]) : "v"(PG8_LO(Bt[n])), "v"(PG8_LO(At[mm]))); \
                _Pragma("unroll") for (int mm = m; mm < m + 2; ++mm) _Pragma("unroll") for (int n = 0; n < 2; ++n) \
                    asm volatile("v_mfma_f32_16x16x32_bf16 %0, %1, %2, %0" : "+v"(acc[ai][bj][mm][n]) : "v"(PG8_HI(Bt[n])), "v"(PG8_HI(At[mm]))); } } \
        else { _Pragma("unroll") for (int m = 0; m < 4; ++m) _Pragma("unroll") for (int n = 0; n < 2; ++n) { \
               acc[ai][bj][m][n] = __builtin_amdgcn_mfma_f32_16x16x32_bf16(PG8_LO(Bt[n]), PG8_LO(At[m]), acc[ai][bj][m][n], 0, 0, 0); \
               acc[ai][bj][m][n] = __builtin_amdgcn_mfma_f32_16x16x32_bf16(PG8_HI(Bt[n]), PG8_HI(At[m]), acc[ai][bj][m][n], 0, 0, 0); } } \
        __builtin_amdgcn_s_setprio(0); } while (0)
#define PG8_MMAZ(ai, bj, At, Bt) do { __builtin_amdgcn_s_setprio(1);   \
        _Pragma("unroll") for (int m = 0; m < 4; ++m) _Pragma("unroll") for (int n = 0; n < 2; ++n) { \
            if constexpr (FP8) asm volatile("v_mfma_f32_16x16x128_f8f6f4 %0, %1, %2, 0" : "=&v"(acc[ai][bj][m][n]) : "v"(Bt[n]), "v"(At[m])); \
            else asm volatile("v_mfma_f32_16x16x32_bf16 %0, %1, %2, 0" : "=&v"(acc[ai][bj][m][n]) : "v"(PG8_LO(Bt[n])), "v"(PG8_LO(At[m]))); } \
        if constexpr (!FP8) { if constexpr (Epi::ASM_BF16) { _Pragma("unroll") for (int m = 0; m < 4; ++m) _Pragma("unroll") for (int n = 0; n < 2; ++n) \
                asm volatile("v_mfma_f32_16x16x32_bf16 %0, %1, %2, %0" : "+v"(acc[ai][bj][m][n]) : "v"(PG8_HI(Bt[n])), "v"(PG8_HI(At[m]))); } \
            else { asm volatile("s_nop 7" ::: "memory"); _Pragma("unroll") for (int m = 0; m < 4; ++m) _Pragma("unroll") for (int n = 0; n < 2; ++n) \
                acc[ai][bj][m][n] = __builtin_amdgcn_mfma_f32_16x16x32_bf16(PG8_HI(Bt[n]), PG8_HI(At[m]), acc[ai][bj][m][n], 0, 0, 0); } } \
        __builtin_amdgcn_s_setprio(0); } while (0)
#define PG8_WAIT_V(n) asm volatile("s_waitcnt vmcnt(" #n ")" ::: "memory")
#define PG8_WAIT_V8(relaxed) do { if (relaxed) asm volatile("s_waitcnt vmcnt(%0)" :: "n"(8 + Epi::NST) : "memory"); else asm volatile("s_waitcnt vmcnt(8)" ::: "memory"); } while (0)
#define PG8_WAIT_L(n) asm volatile("s_waitcnt lgkmcnt(" #n ")" ::: "memory")
#define PG8_BAR __builtin_amdgcn_s_barrier()
#define PG8_SCHED __builtin_amdgcn_sched_barrier(0)
    Unit cur, nxt; int ui = 0;
    if (!S.next(0, cur)) return;
    PG8_LAS unsigned short* tab = (PG8_LAS unsigned short*)(lds + g.tab_off);
    if constexpr (AG) {
        int nu = 1; { Unit uu; while (S.next(nu, uu)) ++nu; }
        for (int idx = tid; idx < nu * 256; idx += 512) { Unit uu; S.next(idx >> 8, uu); tab[idx] = (unsigned short)g.gtok[uu.pm * 256 + (idx & 255)]; }
        asm volatile("s_waitcnt vmcnt(0) lgkmcnt(0)" ::: "memory"); __builtin_amdgcn_s_barrier(); asm volatile("" ::: "memory");
    }
    unsigned cvA[2][2], nvA[2][2];
#pragma unroll
    for (int h = 0; h < 2; ++h)
#pragma unroll
        for (int i = 0; i < 2; ++i) { cvA[h][i] = AG ? ((unsigned)((cur.pm & 31) * 2048) + (unsigned)tab[128 * h + rowA[i]]) * (unsigned)g.lda + (unsigned)colA[i] : voffA[i]; nvA[h][i] = cvA[h][i]; }
    f32x4 acc[2][2][4][2];
#pragma unroll
    for (int a = 0; a < 2; ++a)
#pragma unroll
        for (int b = 0; b < 2; ++b)
#pragma unroll
            for (int m = 0; m < 4; ++m)
#pragma unroll
                for (int n = 0; n < 2; ++n) acc[a][b][m][n] = (f32x4){0.f, 0.f, 0.f, 0.f};
    v8i_t At[4], B0[2], B1[2];
    unsigned cA = AG ? 0u : (unsigned)cur.pm * tstepA, cB = (unsigned)cur.pb * tstepB;
    PG8_STAGE(PG8_SB(0, 0), rsB, cB, voffB); PG8_STAGE(PG8_SB(0, 1), rsB, cB + hstepB, voffB); PG8_STAGE(PG8_SA(0, 0), rsA, cA, cvA[0]); PG8_STAGE(PG8_SA(0, 1), rsA, cA + hstepA, cvA[1]);
    if (wr == 1) PG8_BAR;
    PG8_WAIT_V(2); PG8_BAR;
    PG8_STAGE(PG8_SB(1, 0), rsB, cB + kstep, voffB); PG8_STAGE(PG8_SA(1, 0), rsA, cA + kstepA, cvA[0]); PG8_STAGE(PG8_SB(1, 1), rsB, cB + hstepB + kstep, voffB);
    PG8_WAIT_V(6); PG8_BAR;
    for (;;) {
        const bool has_next = S.next(ui + 1, nxt);
        const unsigned nA = (has_next && !AG) ? (unsigned)nxt.pm * tstepA : cA, nB = has_next ? (unsigned)nxt.pb * tstepB : cB;
        if constexpr (AG) { if (has_next) {
#pragma unroll
            for (int h = 0; h < 2; ++h)
#pragma unroll
                for (int i = 0; i < 2; ++i) nvA[h][i] = ((unsigned)((nxt.pm & 31) * 2048) + (unsigned)tab[(ui + 1) * 256 + 128 * h + rowA[i]]) * (unsigned)g.lda + (unsigned)colA[i]; } }
        auto trip = [&](auto ztag, const int t) __attribute__((always_inline)) {
            constexpr bool ZERO = decltype(ztag)::value;
            const bool last = (t == nt * KREP - 2), after_epi = (t == 0) && (ui > 0);
            const int t1 = (KREP > 1) ? (t + 1) % nt : t + 1, t2 = (KREP > 1) ? (t + 2) % nt : t + 2;
            const unsigned a1 = cA + (unsigned)t1 * kstepA;
            const unsigned a2 = last ? nA : cA + (unsigned)t2 * kstepA, b2 = last ? nB : cB + (unsigned)t2 * kstep;
            const unsigned a3 = a2 + kstepA, b3 = b2 + kstep;
            unsigned selA[2][2];
#pragma unroll
            for (int h = 0; h < 2; ++h)
#pragma unroll
                for (int i = 0; i < 2; ++i) selA[h][i] = (AG && last) ? nvA[h][i] : cvA[h][i];
            PG8_LDB(B0, 0, 0); PG8_LDB(B1, 0, 1); PG8_SCHED; PG8_LDA(At, 0, 0); PG8_STAGE(PG8_SA(1, 1), rsA, a1 + hstepA, cvA[1]);
            PG8_WAIT_V8(after_epi); PG8_WAIT_L(0); PG8_BAR; if constexpr (ZERO) { PG8_MMAZ(0, 0, At, B0); PG8_MMAZ(0, 1, At, B1); } else { PG8_MMA(0, 0, At, B0); PG8_MMA(0, 1, At, B1); } PG8_BAR; PG8_SCHED;
            PG8_LDA(At, 0, 1); PG8_STAGE(PG8_SB(0, 0), rsB, b2, voffB); PG8_STAGE(PG8_SB(0, 1), rsB, b2 + hstepB, voffB); PG8_STAGE(PG8_SA(0, 0), rsA, a2, selA[0]);
            PG8_WAIT_V8(after_epi); PG8_WAIT_L(0); PG8_BAR; if constexpr (ZERO) { PG8_MMAZ(1, 0, At, B0); PG8_MMAZ(1, 1, At, B1); } else { PG8_MMA(1, 0, At, B0); PG8_MMA(1, 1, At, B1); } PG8_BAR; PG8_SCHED;
            PG8_LDB(B0, 1, 0); PG8_LDB(B1, 1, 1); PG8_SCHED; PG8_LDA(At, 1, 0); PG8_STAGE(PG8_SA(0, 1), rsA, a2 + hstepA, selA[1]);
            PG8_WAIT_V(8); PG8_WAIT_L(0); PG8_BAR; PG8_MMA(0, 0, At, B0); PG8_MMA(0, 1, At, B1); PG8_BAR; PG8_SCHED;
            PG8_LDA(At, 1, 1); PG8_STAGE(PG8_SB(1, 0), rsB, b3, voffB); PG8_STAGE(PG8_SB(1, 1), rsB, b3 + hstepB, voffB); PG8_STAGE(PG8_SA(1, 0), rsA, a3, selA[0]);
            PG8_WAIT_V(8); PG8_WAIT_L(0); PG8_BAR; PG8_MMA(1, 0, At, B0); PG8_MMA(1, 1, At, B1); PG8_BAR; PG8_SCHED;
                };
        if constexpr (KREP == 1) {
            trip(std::true_type{}, 0);
#pragma unroll 1
            for (int t = 2; t < nt; t += 2) trip(std::false_type{}, t);
        } else {
#pragma unroll 1
            for (int t = 0; t < nt * KREP; t += 2) trip(std::false_type{}, t);
        }
        if constexpr (FP8 || Epi::ASM_BF16) asm volatile("s_nop 15\n\ts_nop 15" ::: "memory");
        if constexpr (ALIGN_EPI) { if (wr == 0) PG8_BAR; }
        E(acc, cur, wr, wc, fr, fq);
        if constexpr (EPIREP > 1) { asm volatile("" ::: "memory"); E(acc, cur, wr, wc, fr, fq); }
        if (!has_next) break;
        if constexpr (KREP > 1) {
#pragma unroll
        for (int a = 0; a < 2; ++a)
#pragma unroll
            for (int b = 0; b < 2; ++b)
#pragma unroll
                for (int m = 0; m < 4; ++m)
#pragma unroll
                    for (int n = 0; n < 2; ++n) acc[a][b][m][n] = (f32x4){0.f, 0.f, 0.f, 0.f}; }
        cur = nxt; cA = nA; cB = nB; ++ui;
#pragma unroll
        for (int h = 0; h < 2; ++h)
#pragma unroll
            for (int i = 0; i < 2; ++i) cvA[h][i] = nvA[h][i];
        if constexpr (ALIGN_EPI) { if (wr == 1) PG8_BAR; }
    }
    PG8_WAIT_V(0);
    if constexpr (!ALIGN_EPI) { if (wr == 0) PG8_BAR; }
    PG8_BAR;
#undef PG8_SA
#undef PG8_SB
#undef PG8_STAGE
#undef PG8_LDA
#undef PG8_LDB
#undef PG8_LDF
#undef PG8_LO
#undef PG8_HI
#undef PG8_MMA
#undef PG8_WAIT_V
#undef PG8_WAIT_V8
#undef PG8_WAIT_L
#undef PG8_BAR
#undef PG8_SCHED
}
}

constexpr int NWAVES = 8;
constexpr int BATCH = 32, SEQ = 2048, DM = 1024, T = BATCH * SEQ, SRC_DIN = 6656, DIN = 5632;
constexpr int NE = 16, CAP = 256, DFF = 2048;
constexpr int S_CB = 1536, S_CC = 2560, S_CX = 3584, S_GA = 4608;
constexpr int OQ = 0, OK_ = 1024, OV = 1280, OCB = 1536, OCC = 2560, OGA = 3584, OGC = 4608;
constexpr int NCHUNK = 1, CBATCH = BATCH / NCHUNK, TC = CBATCH * SEQ;
constexpr int MSLOT = NE * BATCH * CAP;
constexpr float ATT_SCALE = 8.f, WAO_SCALE = 32.f;
constexpr float WIN_SCALE = 32.f, WGU_SCALE = 32.f, WDN_SCALE = 64.f, H_SCALE = 8.f;
constexpr float LN_EPS = 1e-5f, ALPHA = 1.189207115002721f, LOG2E = 1.4426950408889634f;
constexpr float QSCALE = 0.125f * LOG2E;

constexpr size_t MiB = 1u << 20;
constexpr size_t WS_CTL = 0, CTL_ZERO_BYTES = 64 * 1024;
constexpr size_t WS_STATS0 = 1 * MiB;
constexpr size_t WS_STATS1 = WS_STATS0 + 512 * 1024;
constexpr size_t WS_TOKIDX = 2 * MiB;
constexpr size_t WS_TOPVAL = WS_TOKIDX + 512 * 1024;
constexpr size_t WS_INV = 3 * MiB;
constexpr size_t WS_AFF = 5 * MiB;
constexpr size_t WS_WIN8 = 9 * MiB;
constexpr size_t WS_WINC = 14 * MiB;
constexpr int NF8 = 3584, NCV = 3072;
constexpr size_t WS_WAC = 22 * MiB;
constexpr size_t WS_WOUT = 26 * MiB;
constexpr size_t WS_XN = 32 * MiB;
constexpr size_t WS_XN8 = 160 * MiB;
constexpr size_t WS_PROJ = 224 * MiB;
constexpr size_t WS_TMP = WS_XN, WS_ATT8 = WS_XN8;
constexpr size_t WS_WAO8 = 28 * MiB;
constexpr size_t WS_WGU = 224 * MiB;
constexpr size_t WS_WDN = 288 * MiB;
constexpr size_t WS_H = 320 * MiB;
constexpr size_t WS_YE = 576 * MiB;
constexpr size_t WS_END = 928 * MiB;
static_assert(WS_PROJ + (size_t)T * DIN * 2 <= WS_END && WS_YE + (size_t)MSLOT * DM * 2 <= WS_END && WS_H + (size_t)MSLOT * DFF <= WS_YE, "ws map");
static_assert(WS_XN + (size_t)T * DM * 2 <= WS_XN8 && WS_XN8 + (size_t)T * DM <= WS_PROJ && WS_WDN + (size_t)NE * DM * DFF <= WS_H && WS_WGU + (size_t)NE * 2 * DFF * DM <= WS_WDN, "ws map");

constexpr int CW_BAR = 4096;
constexpr int RING_BYTES = 131072, MISC_OFF = RING_BYTES + 320, TAB_OFF = RING_BYTES + 1024  , LDS_BYTES = 155648;

#define GAS __attribute__((address_space(1)))
#define LAS __attribute__((address_space(3)))
typedef unsigned short bf16;
typedef unsigned v4u __attribute__((ext_vector_type(4)));
typedef unsigned v2u __attribute__((ext_vector_type(2)));
typedef float f32x4 __attribute__((ext_vector_type(4)));
typedef float f32x2 __attribute__((ext_vector_type(2)));
typedef float f32x16 __attribute__((ext_vector_type(16)));
typedef short bf16x8 __attribute__((ext_vector_type(8)));
typedef short s16x4 __attribute__((ext_vector_type(4)));
#define LDS_WAIT() asm volatile("s_waitcnt lgkmcnt(0)" ::: "memory")
__device__ __forceinline__ unsigned f2bf(float f) { unsigned u = __builtin_bit_cast(unsigned, f); return (u + 0x7fffu + ((u >> 16) & 1u)) >> 16; }
__device__ __forceinline__ unsigned pk2(float lo, float hi) { return f2bf(lo) | (f2bf(hi) << 16); }
__device__ __forceinline__ float bflo(unsigned u) { return __uint_as_float(u << 16); }
__device__ __forceinline__ float bfhi(unsigned u) { return __uint_as_float(u & 0xffff0000u); }
__device__ __forceinline__ float sigmoidf_(float x) { return __builtin_amdgcn_rcpf(1.0f + __expf(-x)); }
__device__ __forceinline__ unsigned pk4_fp8(float a, float b, float c, float d) { unsigned w = __builtin_amdgcn_cvt_pk_fp8_f32(a, b, 0u, false); return __builtin_amdgcn_cvt_pk_fp8_f32(c, d, w, true); }

#define XB_TMO      128
#define XB_XCNT(j)  (256  + 64 * (j))
#define XB_XSUB(j)  (1280 + 64 * (j))
#define XB_XGEN(j)  (2304 + 64 * (j))
#define XB_TOP      3328
#define XB_TOPGEN   3392
#define XCD_BAR_WORDS 3456
#define XB_SPIN_CAP (1u << 22)
__device__ __forceinline__ unsigned xb_ld(unsigned* p)              { return __hip_atomic_load(p, __ATOMIC_RELAXED, __HIP_MEMORY_SCOPE_AGENT); }
__device__ __forceinline__ unsigned xb_add(unsigned* p, unsigned v) { return __hip_atomic_fetch_add(p, v, __ATOMIC_RELAXED, __HIP_MEMORY_SCOPE_AGENT); }
__device__ __forceinline__ unsigned xb_xcc_id() { return (unsigned)__builtin_amdgcn_s_getreg((3 << 11) | 20) & 0xFu; }
#define XB_SPIN(cond, bar) do { unsigned _sp = 0; while (cond) { __builtin_amdgcn_s_sleep(1); \
    if ((++_sp & 255u) == 0u) { if (xb_ld(&(bar)[XB_TMO])) break; if (_sp > XB_SPIN_CAP) { atomicAdd(&(bar)[XB_TMO], 1u); break; } } } } while (0)
struct XcdBarrier { unsigned* bar; unsigned x; volatile LAS unsigned* st; };
__device__ __forceinline__ XcdBarrier xcd_barrier_post(unsigned* bar, volatile LAS unsigned* st) {
    XcdBarrier b; b.bar = bar; b.x = xb_xcc_id(); b.st = st;
    if (threadIdx.x == 0) (void)xb_add(&bar[XB_XCNT(b.x)], 1u);
    return b;
}
__device__ __forceinline__ void xcd_barrier_complete(unsigned* bar, unsigned x, unsigned& nloc, unsigned& nx) {
    const unsigned G = gridDim.x * gridDim.y * gridDim.z;
    unsigned sum, cnt, mine, sp = 0u;
    for (;;) {
        sum = 0u; cnt = 0u; mine = 0u;
#pragma unroll
        for (unsigned j = 0; j < 16; ++j) { const unsigned c = xb_ld(&bar[XB_XCNT(j)]); sum += c; cnt += (c > 0u) ? 1u : 0u; mine = (j == x) ? c : mine; }
        if (sum == G) break;
        __builtin_amdgcn_s_sleep(1);
        if ((++sp & 255u) == 0u) { if (xb_ld(&bar[XB_TMO])) break; if (sp > XB_SPIN_CAP) { atomicAdd(&bar[XB_TMO], 1u); break; } }
    }
    nloc = mine > 0u ? mine : 1u; nx = cnt > 0u ? cnt : 1u;
}
__device__ __forceinline__ void xcd_barrier(const XcdBarrier& b) {
    asm volatile("s_waitcnt vmcnt(0)" ::: "memory");
    __syncthreads();
    if (threadIdx.x == 0) {
        unsigned* bar = b.bar;
        __builtin_amdgcn_s_waitcnt(0);
        unsigned nloc = b.st[0], nx = b.st[1];
        if (nloc == 0u) { xcd_barrier_complete(bar, b.x, nloc, nx); b.st[0] = nloc; b.st[1] = nx; }
        const unsigned old = xb_add(&bar[XB_XSUB(b.x)], 1u);
        const unsigned gen = old / nloc;
        if (old + 1u == (gen + 1u) * nloc) {
            __builtin_amdgcn_fence(__ATOMIC_RELEASE, "agent");
            asm volatile("s_waitcnt vmcnt(0)" ::: "memory");
            const unsigned og = xb_add(&bar[XB_TOP], 1u);
            const unsigned tg = og / nx;
            if (og + 1u == (tg + 1u) * nx) xb_add(&bar[XB_TOPGEN], 1u);
            else XB_SPIN(xb_ld(&bar[XB_TOPGEN]) == tg, bar);
            __builtin_amdgcn_fence(__ATOMIC_ACQUIRE, "agent");
            xb_add(&bar[XB_XGEN(b.x)], 1u);
            asm volatile("s_waitcnt vmcnt(0)" ::: "memory");
        } else {
            XB_SPIN(xb_ld(&bar[XB_XGEN(b.x)]) == gen, bar);
            __builtin_amdgcn_fence(__ATOMIC_ACQUIRE, "agent");
            asm volatile("s_waitcnt vmcnt(0)" ::: "memory");
        }
    }
    __syncthreads();
}

__device__ __forceinline__ float wave_sum(float v) {
#pragma unroll
    for (int o = 1; o < 64; o <<= 1) v += __shfl_xor(v, o);
    return v;
}

using pg8::Unit; using pg8::bf16_t;
template <int BANK> __device__ __forceinline__ unsigned dpp_x8(unsigned old, unsigned src) { return (unsigned)__builtin_amdgcn_update_dpp((int)old, (int)src, 0x128  , 0xf, BANK, false); }
__device__ __forceinline__ void widen(const f32x4& a0, const f32x4& a1, bool, f32x4& xa, f32x4& xb) {
#pragma unroll
    for (int j = 0; j < 4; ++j) { const unsigned u0 = __float_as_uint(a0[j]), u1 = __float_as_uint(a1[j]);
        xa[j] = __uint_as_float(dpp_x8<0xC>(u0, u1));
        xb[j] = __uint_as_float(dpp_x8<0x3>(u1, u0)); }
}
__device__ __forceinline__ void widen_pk(const v4u& p0, const v4u& p1, v4u& xa, v4u& xb) {
    xa.x = dpp_x8<0xC>(p0.x, p1.x); xa.y = dpp_x8<0xC>(p0.y, p1.y); xa.z = dpp_x8<0xC>(p0.z, p1.z); xa.w = dpp_x8<0xC>(p0.w, p1.w);
    xb.x = dpp_x8<0x3>(p1.x, p0.x); xb.y = dpp_x8<0x3>(p1.y, p0.y); xb.z = dpp_x8<0x3>(p1.z, p0.z); xb.w = dpp_x8<0x3>(p1.w, p0.w);
}
__device__ __forceinline__ v4u pack8(const f32x4& v0, const f32x4& v1) { v4u w; w.x = pg8::cvt_pk_bf16(v0[0], v0[1]); w.y = pg8::cvt_pk_bf16(v0[2], v0[3]); w.z = pg8::cvt_pk_bf16(v1[0], v1[1]); w.w = pg8::cvt_pk_bf16(v1[2], v1[3]); return w; }
#ifndef THIN_NT
#define THIN_NT 1
#endif
#if THIN_NT
#define NT_LD(p) __builtin_nontemporal_load(p)
#define NT_ST(p, v) __builtin_nontemporal_store((v), (p))
#else
#define NT_LD(p) (*(p))
#define NT_ST(p, v) (*(p) = (v))
#endif
#ifndef EPI_NT
#define EPI_NT 1
#endif
#if EPI_NT
#define EPI_ST(p, v) __builtin_nontemporal_store((v), (p))
#else
#define EPI_ST(p, v) (*(p) = (v))
#endif
template <int MODE> struct EpiProj {
    static constexpr bool PERM = true; static constexpr bool ASM_BF16 = false; static constexpr int NST = 8;
    bf16* O;
    __device__ __forceinline__ void operator()(const f32x4 (&acc)[2][2][4][2], const Unit& u, int wr, int wc, int fr, int fq) const {
        const int colt = MODE == 0 ? (u.pn < 6 ? u.pn * 256 : OGA + (u.pn - 6) * 256) : OCB + u.pn * 256;
        const float sc = MODE == 0 ? ((u.pn < 4) ? QSCALE / WIN_SCALE : 1.f / WIN_SCALE) : 1.f;
        const bool hi8 = fr >= 8; const int row0 = u.pm * 256 + wr * 64 + (fr & 7), col0 = colt + wc * 64 + (hi8 ? 32 : 0) + 8 * fq;
        if (MODE == 1 && u.pn >= 4) {
            const int r0 = u.pm * 256 + wr * 64 + fr, c0 = OCC + (u.pn - 4) * 128 + wc * 32 + 8 * fq;
#pragma unroll
            for (int ai = 0; ai < 2; ++ai)
#pragma unroll
                for (int m = 0; m < 4; ++m) EPI_ST((v4u*)(O + (size_t)(r0 + ai * 128 + m * 16) * DIN + c0), pack8(acc[ai][0][m][0] * acc[ai][1][m][0], acc[ai][0][m][1] * acc[ai][1][m][1]));
            return; }
#pragma unroll
        for (int ai = 0; ai < 2; ++ai)
#pragma unroll
            for (int m = 0; m < 4; ++m) { bf16* rowp = O + (size_t)(row0 + ai * 128 + m * 16) * DIN + col0;
                v4u xa, xb; widen_pk(pack8(acc[ai][0][m][0] * sc, acc[ai][0][m][1] * sc), pack8(acc[ai][1][m][0] * sc, acc[ai][1][m][1] * sc), xa, xb);
                EPI_ST((v4u*)rowp, xa); EPI_ST((v4u*)(rowp + 8 * DIN), xb); }
    }
};
#ifndef EG_D0
#define EG_D0 7
#endif
#ifndef EG_D1
#define EG_D1 3
#endif
template <int MODE> struct EpiGate {
    static constexpr bool PERM = true; static constexpr bool ASM_BF16 = (MODE == 1);   static constexpr int NST = 0;
    const bf16* proj; bf16* tmp; int gcol0;
    struct Step { v4u ga, gb, ta, tb; };
    __device__ __forceinline__ void operator()(const f32x4 (&acc)[2][2][4][2], const Unit& u, int wr, int wc, int fr, int fq) const {
        const bool hi8 = fr >= 8; const int row0 = u.pm * 256 + wr * 64 + (fr & 7), col0 = u.pn * 256 + wc * 64 + (hi8 ? 32 : 0) + 8 * fq;
        constexpr float SC = MODE == 0 ? 1.0f / (ATT_SCALE * WAO_SCALE) : 1.0f;
        constexpr int D = MODE == 0 ? EG_D0 : EG_D1;
        const char* gb_ = (const char*)proj; char* tb_ = (char*)tmp;
        const unsigned g0 = (unsigned)(row0 * DIN + gcol0 + col0) * 2u, t0 = (unsigned)(row0 * DM + col0) * 2u;
        Step q[D + 1];
        auto issue = [&](int s, Step& r) { const unsigned dr = (unsigned)((s >> 2) * 128 + (s & 3) * 16);
            r.ga = NT_LD((const v4u*)(gb_ + g0 + dr * (unsigned)(DIN * 2))); r.gb = NT_LD((const v4u*)(gb_ + g0 + (dr + 8u) * (unsigned)(DIN * 2)));
            if (MODE == 1) { r.ta = *(const v4u*)(tb_ + t0 + dr * (unsigned)(DM * 2)); r.tb = *(const v4u*)(tb_ + t0 + (dr + 8u) * (unsigned)(DM * 2)); } };
#pragma unroll
        for (int s = 0; s < D; ++s) issue(s, q[s]);
#pragma unroll
        for (int st = 0; st < 8; ++st) { const int ai = st >> 2, m = st & 3;
            if (st + D < 8) issue(st + D, q[(st + D) % (D + 1)]);
            const Step& c = q[st % (D + 1)];
            const unsigned dr = (unsigned)(ai * 128 + m * 16);
            f32x4 xa0, xb0, xa1, xb1; widen(acc[ai][0][m][0], acc[ai][1][m][0], hi8, xa0, xb0); widen(acc[ai][0][m][1], acc[ai][1][m][1], hi8, xa1, xb1);
#pragma unroll
            for (int s = 0; s < 2; ++s) {
                const f32x4 y0 = s ? xb0 : xa0, y1 = s ? xb1 : xa1; const v4u g4 = s ? c.gb : c.ga; float r[8], y[8];
                r[0] = bflo(g4.x); r[1] = bfhi(g4.x); r[2] = bflo(g4.y); r[3] = bfhi(g4.y); r[4] = bflo(g4.z); r[5] = bfhi(g4.z); r[6] = bflo(g4.w); r[7] = bfhi(g4.w);
#pragma unroll
                for (int k = 0; k < 4; ++k) { y[k] = y0[k]; y[4 + k] = y1[k]; }
#pragma unroll
                for (int k = 0; k < 8; ++k) r[k] = __builtin_amdgcn_exp2f(r[k] * -LOG2E);
#pragma unroll
                for (int k = 0; k < 8; ++k) r[k] = __builtin_fmaf(r[k], 1.0f / SC, 1.0f / SC);
#pragma unroll
                for (int k = 0; k < 8; ++k) r[k] = __builtin_amdgcn_rcpf(r[k]);
                if (MODE == 1) { const v4u t4 = s ? c.tb : c.ta; float tq[8];
                    tq[0] = bflo(t4.x); tq[1] = bfhi(t4.x); tq[2] = bflo(t4.y); tq[3] = bfhi(t4.y); tq[4] = bflo(t4.z); tq[5] = bfhi(t4.z); tq[6] = bflo(t4.w); tq[7] = bfhi(t4.w);
#pragma unroll
                    for (int k = 0; k < 8; ++k) r[k] = __builtin_fmaf(y[k], r[k], tq[k]);
                } else {
#pragma unroll
                    for (int k = 0; k < 8; ++k) r[k] = y[k] * r[k]; }
                v4u w; w.x = pg8::cvt_pk_bf16(r[0], r[1]); w.y = pg8::cvt_pk_bf16(r[2], r[3]); w.z = pg8::cvt_pk_bf16(r[4], r[5]); w.w = pg8::cvt_pk_bf16(r[6], r[7]);
                *(v4u*)(tb_ + t0 + (dr + 8u * s) * (unsigned)(DM * 2)) = w; }
        }
    }
};
struct EpiPlain {
    static constexpr bool PERM = true; static constexpr bool ASM_BF16 = false; static constexpr int NST = 8;
    bf16* tmp;
    __device__ __forceinline__ void operator()(const f32x4 (&acc)[2][2][4][2], const Unit& u, int wr, int wc, int fr, int fq) const {
        const bool hi8 = fr >= 8; const int row0 = u.pm * 256 + wr * 64 + (fr & 7), col0 = u.pn * 256 + wc * 64 + (hi8 ? 32 : 0) + 8 * fq;
        constexpr float sc = 1.0f / (ATT_SCALE * WAO_SCALE);
#pragma unroll
        for (int ai = 0; ai < 2; ++ai)
#pragma unroll
            for (int m = 0; m < 4; ++m) { bf16* rowp = tmp + (size_t)(row0 + ai * 128 + m * 16) * DM + col0;
                v4u xa, xb; widen_pk(pack8(acc[ai][0][m][0] * sc, acc[ai][0][m][1] * sc), pack8(acc[ai][1][m][0] * sc, acc[ai][1][m][1] * sc), xa, xb);
                *(v4u*)rowp = xa; *(v4u*)(rowp + 8 * DM) = xb; }
    }
};
#ifndef EG2_D
#define EG2_D 2
#endif
struct EpiGate2 {
    static constexpr bool PERM = true; static constexpr bool ASM_BF16 = true; static constexpr int NST = 0;
    const bf16* proj; bf16* tmp;
    struct Step { v4u ca, cb, aa, ab, ta, tb; };
    __device__ __forceinline__ void operator()(const f32x4 (&acc)[2][2][4][2], const Unit& u, int wr, int wc, int fr, int fq) const {
        const bool hi8 = fr >= 8; const int row0 = u.pm * 256 + wr * 64 + (fr & 7), col0 = u.pn * 256 + wc * 64 + (hi8 ? 32 : 0) + 8 * fq;
        constexpr int D = EG2_D;
        const char* gb_ = (const char*)proj; char* tb_ = (char*)tmp;
        const unsigned gc0 = (unsigned)(row0 * DIN + OGC + col0) * 2u, ga0 = (unsigned)(row0 * DIN + OGA + col0) * 2u, t0 = (unsigned)(row0 * DM + col0) * 2u;
        Step q[D + 1];
        auto issue = [&](int s, Step& r) { const unsigned dr = (unsigned)((s >> 2) * 128 + (s & 3) * 16);
            r.ca = NT_LD((const v4u*)(gb_ + gc0 + dr * (unsigned)(DIN * 2))); r.cb = NT_LD((const v4u*)(gb_ + gc0 + (dr + 8u) * (unsigned)(DIN * 2)));
            r.aa = NT_LD((const v4u*)(gb_ + ga0 + dr * (unsigned)(DIN * 2))); r.ab = NT_LD((const v4u*)(gb_ + ga0 + (dr + 8u) * (unsigned)(DIN * 2)));
            r.ta = *(const v4u*)(tb_ + t0 + dr * (unsigned)(DM * 2)); r.tb = *(const v4u*)(tb_ + t0 + (dr + 8u) * (unsigned)(DM * 2)); };
#pragma unroll
        for (int s = 0; s < D; ++s) issue(s, q[s]);
#pragma unroll
        for (int st = 0; st < 8; ++st) { const int ai = st >> 2, m = st & 3;
            if (st + D < 8) issue(st + D, q[(st + D) % (D + 1)]);
            const Step& c = q[st % (D + 1)];
            const unsigned dr = (unsigned)(ai * 128 + m * 16);
            f32x4 xa0, xb0, xa1, xb1; widen(acc[ai][0][m][0], acc[ai][1][m][0], hi8, xa0, xb0); widen(acc[ai][0][m][1], acc[ai][1][m][1], hi8, xa1, xb1);
#pragma unroll
            for (int s = 0; s < 2; ++s) {
                const f32x4 y0 = s ? xb0 : xa0, y1 = s ? xb1 : xa1; const v4u g4 = s ? c.cb : c.ca, a4 = s ? c.ab : c.aa, t4 = s ? c.tb : c.ta; float r[8], ra[8];
                ra[0] = bflo(a4.x); ra[1] = bfhi(a4.x); ra[2] = bflo(a4.y); ra[3] = bfhi(a4.y); ra[4] = bflo(a4.z); ra[5] = bfhi(a4.z); ra[6] = bflo(a4.w); ra[7] = bfhi(a4.w);
#pragma unroll
                for (int k = 0; k < 8; ++k) ra[k] = __builtin_amdgcn_exp2f(ra[k] * -LOG2E);
#pragma unroll
                for (int k = 0; k < 8; ++k) ra[k] = __builtin_amdgcn_rcpf(1.0f + ra[k]);
                ra[0] *= bflo(t4.x); ra[1] *= bfhi(t4.x); ra[2] *= bflo(t4.y); ra[3] *= bfhi(t4.y); ra[4] *= bflo(t4.z); ra[5] *= bfhi(t4.z); ra[6] *= bflo(t4.w); ra[7] *= bfhi(t4.w);
                asm volatile("" ::: "memory");
                r[0] = bflo(g4.x); r[1] = bfhi(g4.x); r[2] = bflo(g4.y); r[3] = bfhi(g4.y); r[4] = bflo(g4.z); r[5] = bfhi(g4.z); r[6] = bflo(g4.w); r[7] = bfhi(g4.w);
#pragma unroll
                for (int k = 0; k < 8; ++k) r[k] = __builtin_amdgcn_exp2f(r[k] * -LOG2E);
#pragma unroll
                for (int k = 0; k < 8; ++k) r[k] = __builtin_amdgcn_rcpf(1.0f + r[k]);
#pragma unroll
                for (int k = 0; k < 4; ++k) { r[k] = __builtin_fmaf(y0[k], r[k], ra[k]); r[4 + k] = __builtin_fmaf(y1[k], r[4 + k], ra[4 + k]); }
                v4u w; w.x = pg8::cvt_pk_bf16(r[0], r[1]); w.y = pg8::cvt_pk_bf16(r[2], r[3]); w.z = pg8::cvt_pk_bf16(r[4], r[5]); w.w = pg8::cvt_pk_bf16(r[6], r[7]);
                *(v4u*)(tb_ + t0 + (dr + 8u * s) * (unsigned)(DM * 2)) = w; }
        }
    }
};
#ifndef RESID_D
#define RESID_D 4
#endif
struct EpiResid {
    static constexpr bool PERM = true; static constexpr bool ASM_BF16 = true; static constexpr int NST = 8;
    bf16* out; int row_off;
    __device__ __forceinline__ void operator()(const f32x4 (&acc)[2][2][4][2], const Unit& u, int wr, int wc, int fr, int fq) const {
        const bool hi8 = fr >= 8; const int row0 = row_off + u.pm * 256 + wr * 64 + (fr & 7), col0 = u.pn * 256 + wc * 64 + (hi8 ? 32 : 0) + 8 * fq;
#pragma unroll
        for (int ai = 0; ai < 2; ++ai)
#pragma unroll
            for (int m = 0; m < 4; ++m) { bf16* rowp = out + (size_t)(row0 + ai * 128 + m * 16) * DM + col0;
                v4u xa, xb; widen_pk(pack8(acc[ai][0][m][0], acc[ai][0][m][1]), pack8(acc[ai][1][m][0], acc[ai][1][m][1]), xa, xb);
                *(v4u*)rowp = xa; *(v4u*)(rowp + 8 * DM) = xb; }
    }
};
struct EpiSwiglu {
    static constexpr bool PERM = true; static constexpr bool ASM_BF16 = false; static constexpr int NST = 4;
    unsigned char* H;
    __device__ __forceinline__ void operator()(const f32x4 (&acc)[2][2][4][2], const Unit& u, int wr, int wc, int fr, int fq) const {
        const int rb0 = u.pm * 16 + wr * 4 + (fq & 1), tile0 = (u.pn * 4 + wc) * 512 + fr * 32 + (fq & ~1) * 8;
        constexpr float SI = 1.0f / (WGU_SCALE * PROBE_KREP);
        constexpr float C1 = -SI * LOG2E, KD = 1.0f / (SI * SI * H_SCALE);
#pragma unroll
        for (int ai = 0; ai < 2; ++ai)
#pragma unroll
            for (int m2 = 0; m2 < 4; m2 += 2) { v2u w[2];
#pragma unroll
                for (int mm = 0; mm < 2; ++mm) { const int m = m2 + mm; float t[8], gu[8];
#pragma unroll
                    for (int k = 0; k < 8; ++k) { const float G = acc[ai][0][m][k >> 2][k & 3], U = acc[ai][1][m][k >> 2][k & 3]; t[k] = (G * C1); gu[k] = (G * U); }
#pragma unroll
                    for (int k = 0; k < 8; ++k) t[k] = __builtin_amdgcn_exp2f(t[k]);
#pragma unroll
                    for (int k = 0; k < 8; ++k) t[k] = __builtin_fmaf(t[k], KD, KD);
#pragma unroll
                    for (int k = 0; k < 8; ++k) t[k] = __builtin_amdgcn_rcpf(t[k]);
#pragma unroll
                    for (int k = 0; k < 8; ++k) t[k] = (gu[k] * t[k]);
                    w[mm].x = pk4_fp8(t[0], t[1], t[2], t[3]); w[mm].y = pk4_fp8(t[4], t[5], t[6], t[7]); }
                const auto px = __builtin_amdgcn_permlane16_swap(w[0].x, w[1].x, false, false), py = __builtin_amdgcn_permlane16_swap(w[0].y, w[1].y, false, false);
                const v4u o = {px[0], py[0], px[1], py[1]};
                EPI_ST((v4u*)(H + (size_t)(rb0 + ai * 8 + m2) * (16 * DFF) + tile0), o); }
    }
};
struct EpiDown {
    static constexpr bool PERM = true; static constexpr bool ASM_BF16 = false; static constexpr int NST = 16;
    bf16* Y; const float* topval;
    __device__ __forceinline__ void operator()(const f32x4 (&acc)[2][2][4][2], const Unit& u, int wr, int wc, int fr, int fq) const {
        const bool hi8 = fr >= 8; const int row0 = u.pm * 256 + wr * 64 + (fr & 7), col0 = u.pn * 256 + wc * 64 + (hi8 ? 32 : 0) + 8 * fq;
        float tsc[2][4];
#pragma unroll
        for (int ai = 0; ai < 2; ++ai)
#pragma unroll
            for (int m = 0; m < 4; ++m) tsc[ai][m] = topval[u.pm * 256 + wr * 64 + fr + ai * 128 + m * 16];
#pragma unroll
        for (int ai = 0; ai < 2; ++ai)
#pragma unroll
            for (int m = 0; m < 4; ++m) { const int row = row0 + ai * 128 + m * 16; const float t = tsc[ai][m] * (1.0f / (H_SCALE * WDN_SCALE)); bf16* rowp = Y + (size_t)row * DM + col0;
                v4u xa, xb; widen_pk(pack8(acc[ai][0][m][0] * t, acc[ai][0][m][1] * t), pack8(acc[ai][1][m][0] * t, acc[ai][1][m][1] * t), xa, xb);
                EPI_ST((v4u*)rowp, xa); EPI_ST((v4u*)(rowp + 8 * DM), xb); }
    }
};

__device__ __forceinline__ void transpose_item(const float* __restrict__ Wblk, int N, bf16* dst, int ldo, LAS float* scr, int lane) {
#pragma unroll 8
    for (int i = 0; i < 32; ++i) { const int kk = 2 * i + (lane >> 5); scr[kk * 33 + (lane & 31)] = NT_LD(Wblk + (size_t)kk * N + (lane & 31)); }
    LDS_WAIT(); asm volatile("" ::: "memory");
    const int c = lane & 7;
#pragma unroll
    for (int j = 0; j < 4; ++j) { const int n = (lane >> 3) + 8 * j; const LAS float* s = scr + (8 * c) * 33 + n;
        v4u o; o.x = pk2(s[0 * 33], s[1 * 33]); o.y = pk2(s[2 * 33], s[3 * 33]); o.z = pk2(s[4 * 33], s[5 * 33]); o.w = pk2(s[6 * 33], s[7 * 33]);
        *(v4u*)(dst + (size_t)n * ldo + 8 * c) = o; }
    LDS_WAIT(); asm volatile("" ::: "memory");
}

__device__ __forceinline__ void transpose_item8(const float* __restrict__ Wblk, int N, unsigned char* dst, int ldo, float scale, LAS float* scr, int lane) {
#pragma unroll 8
    for (int i = 0; i < 32; ++i) { const int kk = 2 * i + (lane >> 5); scr[kk * 33 + (lane & 31)] = NT_LD(Wblk + (size_t)kk * N + (lane & 31)) * scale; }
    LDS_WAIT(); asm volatile("" ::: "memory");
    const int c = lane & 3;
#pragma unroll
    for (int j = 0; j < 2; ++j) { const int n = (lane >> 2) + 16 * j; const LAS float* s = scr + (16 * c) * 33 + n;
        v4u o; o.x = pk4_fp8(s[0 * 33], s[1 * 33], s[2 * 33], s[3 * 33]); o.y = pk4_fp8(s[4 * 33], s[5 * 33], s[6 * 33], s[7 * 33]);
        o.z = pk4_fp8(s[8 * 33], s[9 * 33], s[10 * 33], s[11 * 33]); o.w = pk4_fp8(s[12 * 33], s[13 * 33], s[14 * 33], s[15 * 33]);
        *(v4u*)(dst + (size_t)n * ldo + 16 * c) = o; }
    LDS_WAIT(); asm volatile("" ::: "memory");
}

struct Args { const float* in[17]; float* out; unsigned char* ws; int lo, hi; };
#define CAS __attribute__((address_space(4)))
__device__ __forceinline__ const void* karg(int byte_off) {
    const CAS char* kp = (const CAS char*)__builtin_amdgcn_kernarg_segment_ptr(); asm volatile("" : "+s"(kp)); return *(const void* const CAS*)(kp + byte_off); }

__device__ __forceinline__ f32x16 mfma32(bf16x8 a, bf16x8 b, f32x16 c) { return __builtin_amdgcn_mfma_f32_32x32x16_bf16(a, b, c, 0, 0, 0); }
__device__ __forceinline__ s16x4 vtr(LAS unsigned char* p) { return __builtin_bit_cast(s16x4, __builtin_amdgcn_ds_read_tr16_b64_v4i16((LAS s16x4*)p)); }
__device__ __forceinline__ void attn_dma_chunk(LAS unsigned char* lds, const bf16* __restrict__ proj, int bl, int g, int pc, int wave, int lane) {
    if (pc < 0 || pc >= SEQ / 128) return;
    const int slot = (pc + 1) & 3;
#pragma unroll
    for (int h = 0; h < 2; ++h) { const int q = wave + 8 * h, r = 8 * q + (lane >> 3), pch = lane & 7;
        const bf16* rowp = proj + (size_t)(bl * SEQ + pc * 128 + r) * DIN + g * 64;
        __builtin_amdgcn_global_load_lds((const unsigned*)(rowp + OK_ + ((pch ^ ((r >> 1) & 7)) << 3)), (LAS unsigned*)(lds + slot * 16384 + q * 1024), 16, 0, 0);
        __builtin_amdgcn_global_load_lds((const unsigned*)(rowp + OV + ((pch ^ (((r >> 1) & 1) << 2)) << 3)), (LAS unsigned*)(lds + 65536 + slot * 16384 + q * 1024), 16, 0, 0); }
}
__device__ __forceinline__ void attn_run(LAS unsigned char* lds, const bf16* __restrict__ proj, unsigned char* __restrict__ ao, const float* __restrict__ sink,
                                         int bl, int g, int n0, int lane, int wave) {
    const int ql = lane & 31, h5 = lane >> 5, rb = wave & 3, hp = wave >> 2;
    float slope2[2], sink2[2];
#pragma unroll
    for (int hh = 0; hh < 2; ++hh) { const int head = 4 * g + 2 * hp + hh; sink2[hh] = sink[head] * LOG2E; slope2[hh] = exp2f(-0.5f * (float)(head + 1)) * LOG2E; }
    const int sw = (ql >> 1) & 7;
    int koff[4];
#pragma unroll
    for (int ks = 0; ks < 4; ++ks) koff[ks] = ql * 128 + (((2 * ks + h5) ^ sw) << 4);
    const int i16 = lane & 15, g16 = (lane >> 4) & 1, bsw = (lane >> 3) & 1;
    const int vb0 = 65536 + (4 * h5 + (i16 >> 2)) * 128 + ((((2 * g16) + ((i16 & 3) >> 1)) ^ (4 * bsw)) << 4) + (i16 & 1) * 8;
    const int vb1 = vb0 ^ 64;
    const float qoff = (float)(ql - 4 * h5);
    const bf16* qbase = proj + (size_t)(bl * SEQ + rb * 32 + ql) * DIN + (4 * g + 2 * hp) * 64 + 8 * h5;
    asm volatile("s_waitcnt vmcnt(0) lgkmcnt(0)" ::: "memory"); __builtin_amdgcn_s_barrier(); asm volatile("" ::: "memory");
    attn_dma_chunk(lds, proj, bl, g, n0 - 1, wave, lane); attn_dma_chunk(lds, proj, bl, g, n0, wave, lane); attn_dma_chunk(lds, proj, bl, g, n0 + 1, wave, lane);
    bf16x8 qf[2][4];
#pragma unroll
    for (int hh = 0; hh < 2; ++hh)
#pragma unroll
        for (int ks = 0; ks < 4; ++ks) qf[hh][ks] = *(const bf16x8*)(qbase + (size_t)(n0 * 128) * DIN + hh * 64 + 16 * ks);
#pragma unroll 1
    for (int i = 0; i < 4; ++i) {
        const int n = n0 + i;
        asm volatile("s_waitcnt vmcnt(0) lgkmcnt(0)" ::: "memory"); __builtin_amdgcn_s_barrier(); asm volatile("" ::: "memory");
#pragma unroll
        for (int hh = 0; hh < 2; ++hh)
#pragma unroll
            for (int ks = 0; ks < 4; ++ks) asm volatile("" : "+v"(qf[hh][ks]));
        if (i < 3) attn_dma_chunk(lds, proj, bl, g, n + 2, wave, lane);
        const int tq = n * 128 + rb * 32 + ql;
        const int dlo = (n == 0) ? 4 - rb : 0, dhi = (n == SEQ / 128 - 1) ? 7 - rb : 8;
#define ATT_BOFF(dd) ((((n + ((rb + (dd)) >> 2)) & 3) * 16384) + (((rb + (dd)) & 3) * 4096))
#define ATT_LDK(dst, dd) do { const int bo_ = ATT_BOFF(dd); _Pragma("unroll") for (int ks = 0; ks < 4; ++ks) dst[ks] = *(const LAS bf16x8*)(lds + bo_ + koff[ks]); } while (0)
#define ATT_LDV(dst, dd) do { const int bo_ = ATT_BOFF(dd); _Pragma("unroll") for (int s = 0; s < 2; ++s) { \
            const s16x4 a0 = vtr(lds + vb0 + bo_ + s * 2048), a1 = vtr(lds + vb0 + bo_ + s * 2048 + 1024), c0 = vtr(lds + vb1 + bo_ + s * 2048), c1 = vtr(lds + vb1 + bo_ + s * 2048 + 1024); \
            dst[0][s] = __builtin_shufflevector(a0, a1, 0, 1, 2, 3, 4, 5, 6, 7); dst[1][s] = __builtin_shufflevector(c0, c1, 0, 1, 2, 3, 4, 5, 6, 7); } } while (0)
#pragma unroll
        for (int hh = 0; hh < 2; ++hh) {
            f32x16 o0, o1;
#pragma unroll
            for (int r = 0; r < 16; ++r) { o0[r] = 0.f; o1[r] = 0.f; }
            float mrun = sink2[hh], lrun = (h5 == 0) ? 1.f : 0.f;
            const float sl = slope2[hh], sl32 = 32.f * sl;
            bf16x8 kf[4], vf[2][2];
            f32x16 E, S;
            const float sl128 = 128.f * sl;
#pragma unroll
            for (int r = 0; r < 16; ++r) E[r] = -sl * (qoff + (float)(128 - ((r & 3) + 8 * (r >> 2))));
            ATT_LDK(kf, dlo);
            S = mfma32(kf[0], qf[hh][0], E);
#pragma unroll
            for (int ks = 1; ks < 4; ++ks) S = mfma32(kf[ks], qf[hh][ks], S);
#pragma unroll 1
            for (int d = dlo; d <= dhi; ++d) {
                const int dn = d < dhi ? d + 1 : dhi;
                if (d == 4 && dn == 5) {
#pragma unroll
                    for (int ks = 0; ks < 4; ++ks) { v4u w = __builtin_bit_cast(v4u, qf[hh][ks]); w.x ^= 0x80008000u; w.y ^= 0x80008000u; w.z ^= 0x80008000u; w.w ^= 0x80008000u; qf[hh][ks] = __builtin_bit_cast(bf16x8, w); } }
                ATT_LDK(kf, dn);
                f32x16 Sn = mfma32(kf[0], qf[hh][0], E);
#pragma unroll
                for (int ks = 1; ks < 4; ++ks) Sn = mfma32(kf[ks], qf[hh][ks], Sn);
                const float cd = (d <= 4) ? sl32 * (float)d : -sl32 * (float)d, sg = (d <= 4) ? 1.f : -1.f;
                float mb;
                if (d <= 4) {
                    if (d == 0) {
#pragma unroll
                        for (int r = 0; r < 16; ++r) if (E[r] + sl128 < 0.f) S[r] = -INFINITY; }
                    if (d == 4) {
#pragma unroll
                        for (int r = 0; r < 16; ++r) S[r] = __builtin_fmaf(-2.f, fmaxf(E[r] + sl128, 0.f), S[r]); }
                    mb = S[0];
#pragma unroll
                    for (int r = 1; r < 16; ++r) mb = fmaxf(mb, S[r]);
                } else {
                    if (d == 8) {
#pragma unroll
                        for (int r = 0; r < 16; ++r) if (E[r] + sl128 > 0.f) S[r] = INFINITY; }
                    mb = S[0];
#pragma unroll
                    for (int r = 1; r < 16; ++r) mb = fminf(mb, S[r]);
                    mb = -mb;
                }
                { const auto pr = __builtin_amdgcn_permlane32_swap(__float_as_uint(mb), __float_as_uint(mb), false, false); mb = fmaxf(__uint_as_float(pr[0]), __uint_as_float(pr[1])); }
                const float mn = fmaxf(mrun, mb + cd);
                if (!__all(mn == mrun)) {
                    const float alpha = __builtin_amdgcn_exp2f(mrun - mn);
                    lrun *= alpha;
#pragma unroll
                    for (int r = 0; r < 16; ++r) { o0[r] *= alpha; o1[r] *= alpha; }
                    mrun = mn; }
                const float na = cd - mn;
                ATT_LDV(vf, d);
                float ls = 0.f;
#pragma unroll
                for (int r = 0; r < 16; ++r) { const float p = __builtin_amdgcn_exp2f(__builtin_fmaf(sg, S[r], na)); S[r] = p; ls += p; }
                lrun += ls;
                bf16x8 pf[2];
#pragma unroll
                for (int s = 0; s < 2; ++s) { v4u w; w.x = pg8::cvt_pk_bf16(S[8 * s + 0], S[8 * s + 1]); w.y = pg8::cvt_pk_bf16(S[8 * s + 2], S[8 * s + 3]);
                    w.z = pg8::cvt_pk_bf16(S[8 * s + 4], S[8 * s + 5]); w.w = pg8::cvt_pk_bf16(S[8 * s + 6], S[8 * s + 7]); pf[s] = __builtin_bit_cast(bf16x8, w); }
#pragma unroll
                for (int s = 0; s < 2; ++s) { o0 = mfma32(vf[0][s], pf[s], o0); o1 = mfma32(vf[1][s], pf[s], o1); }
                S = Sn;
            }
            const int head = 4 * g + 2 * hp + hh;
            float lt = lrun; { const auto pr = __builtin_amdgcn_permlane32_swap(__float_as_uint(lrun), __float_as_uint(lrun), false, false); lt = __uint_as_float(pr[0]) + __uint_as_float(pr[1]); }
            const float inv = ATT_SCALE / lt;
            unsigned G[8];
#pragma unroll
            for (int rr = 0; rr < 4; ++rr) { G[rr] = pk4_fp8(o0[4 * rr] * inv, o0[4 * rr + 1] * inv, o0[4 * rr + 2] * inv, o0[4 * rr + 3] * inv);
                G[4 + rr] = pk4_fp8(o1[4 * rr] * inv, o1[4 * rr + 1] * inv, o1[4 * rr + 2] * inv, o1[4 * rr + 3] * inv); }
            unsigned W[8];
#pragma unroll
            for (int k = 0; k < 4; ++k) { const auto pr = __builtin_amdgcn_permlane32_swap(G[k], G[k + 4], false, false); W[2 * k] = pr[0]; W[2 * k + 1] = pr[1]; }
            unsigned char* orow = ao + (size_t)(bl * SEQ + tq) * DM + head * 64 + 32 * h5;
            *(v4u*)orow = (v4u){W[0], W[1], W[2], W[3]}; *(v4u*)(orow + 16) = (v4u){W[4], W[5], W[6], W[7]};
        }
#undef ATT_BOFF
#undef ATT_LDK
#undef ATT_LDV
        if (i < 3) {
#pragma unroll
            for (int hh = 0; hh < 2; ++hh)
#pragma unroll
                for (int ks = 0; ks < 4; ++ks) qf[hh][ks] = *(const bf16x8*)(qbase + (size_t)((n + 1) * 128) * DIN + hh * 64 + 16 * ks); }
    }
}

#ifndef STAGGER_TICKS
#define STAGGER_TICKS 0
#endif
__device__ __forceinline__ void stagger_start(int vcu) {
    if (STAGGER_TICKS > 0) { const unsigned long long t0 = __builtin_amdgcn_s_memrealtime(); const unsigned long long d = (unsigned long long)((vcu & 31) * STAGGER_TICKS / 32);
        while (__builtin_amdgcn_s_memrealtime() - t0 < d) __builtin_amdgcn_s_sleep(8); }
}
__global__ void __launch_bounds__(NWAVES * 64, 2) hybrid_fwd(Args args) {
    extern __shared__ __attribute__((aligned(16))) unsigned char lds_raw[];
    LAS unsigned char* lds = (LAS unsigned char*)lds_raw;
    volatile LAS unsigned* MISC = (volatile LAS unsigned*)(lds + MISC_OFF);
    const int G = gridDim.x; const int bx = blockIdx.x; const int vcu = (G % 8 == 0) ? (bx % 8) * (G / 8) + bx / 8 : bx; const int NGW = G * NWAVES;
#define KARG(T_, off) ((T_)karg(off))
#define IN_(i) KARG(const float*, 8 * (i))
#define OUT_() KARG(float*, 136)
#define WSP(T_, off) ((T_)((unsigned char*)karg(144) + (off)))

    for (int u = threadIdx.x; u < (LDS_BYTES - RING_BYTES) / 4; u += NWAVES * 64) ((LAS unsigned*)(lds + RING_BYTES))[u] = 0u;
    __syncthreads();
    const int lo = args.lo, hi = args.hi;
    XcdBarrier bar; bar.bar = WSP(unsigned*, WS_CTL) + CW_BAR; bar.x = 0; bar.st = nullptr;
    if (hi - lo > 1) bar = xcd_barrier_post(WSP(unsigned*, WS_CTL) + CW_BAR, MISC + 8);
    int s = 0;
#define STEP_BEGIN(site) if (lo <= s && s < hi) { for (int rep_ = 0; rep_ < 1 + ((REPEAT_MASK >> (site)) & 1); ++rep_) { int tid_ = threadIdx.x; asm volatile("" : "+v"(tid_)); const int tid = tid_, lane = tid & 63, wave = __builtin_amdgcn_readfirstlane(tid >> 6), gw = vcu * NWAVES + wave; (void)lane; (void)gw;
#define STEP_END   } if (s + 1 < hi) xcd_barrier(bar); } ++s;

    STEP_BEGIN(0)
    {
        LAS float* scr = (LAS float*)(lds + wave * 16384);
        constexpr int I_IN = (DM / 64) * (SRC_DIN / 32), I_SQ = (DM / 64) * (DM / 32);
        constexpr int NITEMS = I_IN + 3 * I_SQ;
        for (int it = gw; it < NITEMS; it += NGW) {
            int r = it;
            if (r < I_IN) { const int nblk = SRC_DIN / 32, kb = r / nblk, nb = r % nblk, n0 = 32 * nb; const float* W = IN_(3) + (size_t)(64 * kb) * SRC_DIN + n0;
                if (n0 >= S_CB && n0 < S_GA) { int orow = n0 - S_CB;
                    if (n0 >= S_CC) { const int which = n0 >= S_CX, chn = n0 - (which ? S_CX : S_CC); orow = 1024 + (chn >> 7) * 256 + ((chn & 127) >> 5) * 64 + which * 32; }
                    transpose_item(W, SRC_DIN, WSP(bf16*, WS_WINC) + (size_t)orow * DM + 64 * kb, DM, scr, lane); }
                else transpose_item8(W, SRC_DIN, WSP(unsigned char*, WS_WIN8) + (size_t)(n0 < S_CB ? n0 : n0 - NCV) * DM + 64 * kb, DM, WIN_SCALE, scr, lane);
                continue; } r -= I_IN;
            { const int which = r / I_SQ, q = r % I_SQ, nblk = DM / 32, kb = q / nblk, nb = q % nblk;
                const float* W = which == 0 ? IN_(6) : (which == 1 ? IN_(7) : IN_(8));
                bf16* dst = which == 2 ? WSP(bf16*, WS_WOUT) + (size_t)(32 * nb) * DM + 64 * kb : WSP(bf16*, WS_WAC) + (size_t)(32 * nb) * (2 * DM) + which * DM + 64 * kb;
                if (which == 0) transpose_item8(W + (size_t)(64 * kb) * DM + 32 * nb, DM, WSP(unsigned char*, WS_WAO8) + (size_t)(32 * nb) * DM + 64 * kb, DM, WAO_SCALE, scr, lane);
                else transpose_item(W + (size_t)(64 * kb) * DM + 32 * nb, DM, dst, which == 2 ? DM : 2 * DM, scr, lane); }
        }
        const float* x = IN_(0); const float* ln0_g = IN_(1); const float* ln0_b = IN_(2); float* stats0 = WSP(float*, WS_STATS0); bf16* XN = WSP(bf16*, WS_XN); unsigned char* XN8 = WSP(unsigned char*, WS_XN8);
        f32x4 gv[4], bv[4];
#pragma unroll
        for (int j = 0; j < 4; ++j) { gv[j] = *(const f32x4*)(ln0_g + 4 * lane + 256 * j); bv[j] = *(const f32x4*)(ln0_b + 4 * lane + 256 * j); }
        for (int m = gw; m < T; m += NGW) {
            const f32x4* xr = (const f32x4*)(x + (size_t)m * DM) + lane;
            f32x4 v[4]; float sm = 0.f;
#pragma unroll
            for (int j = 0; j < 4; ++j) { v[j] = NT_LD(xr + 64 * j); sm += (v[j].x + v[j].y) + (v[j].z + v[j].w); }
            const float mean = wave_sum(sm) * (1.f / DM); float s2 = 0.f;
#pragma unroll
            for (int j = 0; j < 4; ++j) { v[j] = v[j] - mean; s2 += (v[j].x * v[j].x + v[j].y * v[j].y) + (v[j].z * v[j].z + v[j].w * v[j].w); }
            const float rstd = 1.f / sqrtf(wave_sum(s2) * (1.f / DM) + LN_EPS);
            if (lane == 0) *(f32x2*)(stats0 + (size_t)m * 2) = (f32x2){mean, rstd};
            v2u* o8 = (v2u*)(XN + (size_t)m * DM) + lane;
#pragma unroll
            for (int j = 0; j < 4; ++j) { const f32x4 y = v[j] * rstd * gv[j] + bv[j]; v2u w; w.x = pk2(y.x, y.y); w.y = pk2(y.z, y.w); o8[64 * j] = w;
                ((unsigned*)(XN8 + (size_t)m * DM))[lane + 64 * j] = pk4_fp8(y.x, y.y, y.z, y.w); }
        }
    }
    STEP_END

#pragma unroll 1
    for (int c = 0; c < NCHUNK; ++c) {
        STEP_BEGIN(1)
        {
            { pg8::Gemm g{WSP(unsigned char*, WS_XN8) + (size_t)c * TC * DM, WSP(unsigned char*, WS_WIN8), DM, DM, DM / 128}; pg8::StaticOrderT<TC / 256, NF8 / 256> S; S.init(G, bx);
              EpiProj<0> E{WSP(bf16*, WS_PROJ)};
              pg8::gemm_phase<EpiProj<0>, pg8::StaticOrderT<TC / 256, NF8 / 256>, true, true>(lds, g, S, E); }
            { pg8::Gemm g{WSP(bf16*, WS_XN) + (size_t)c * TC * DM, WSP(bf16*, WS_WINC), DM * 2, DM * 2, DM / 64}; pg8::StaticOrderT<TC / 256, NCV / 256> S; S.init(G, bx);
              EpiProj<1> E{WSP(bf16*, WS_PROJ)};
              pg8::gemm_phase<EpiProj<1>, pg8::StaticOrderT<TC / 256, NCV / 256>, true>(lds, g, S, E); }
        }
        STEP_END
        STEP_BEGIN(2)
        {
            const bf16* PROJ = WSP(const bf16*, WS_PROJ); bf16* CONV = (bf16*)OUT_();
            constexpr int NRUN = CBATCH * 4 * (SEQ / 512);
            { const float* attn_sink = IN_(5);
              for (int rp = 0; rp < 1 + ((REPEAT_MASK >> 16) & 1); ++rp)
              for (int u = vcu; u < NRUN; u += G) attn_run(lds, PROJ, WSP(unsigned char*, WS_ATT8), attn_sink, u >> 4, (u >> 2) & 3, (u & 3) * 4, lane, wave); }
            asm volatile("s_waitcnt vmcnt(0) lgkmcnt(0)" ::: "memory"); __builtin_amdgcn_s_barrier(); asm volatile("" ::: "memory");
            const int seg = tid >> 7, cg = tid & 127, ch = cg * 8;
            float w0[8], w1[8], w2[8];
            { const float* conv_w = IN_(4);
#pragma unroll
              for (int j = 0; j < 8; ++j) { w0[j] = conv_w[ch + j]; w1[j] = conv_w[DM + ch + j]; w2[j] = conv_w[2 * DM + ch + j]; } }
            for (int rp = 0; rp < 1 + ((REPEAT_MASK >> 17) & 1); ++rp)
            for (int it = vcu; it < TC / 32; it += G) {
                const int t0 = it * 32 + seg * 8;
                const int sq0 = t0 & (SEQ - 1);
                v4u uv[10], cbv[8];
#pragma unroll
                for (int i = 0; i < 10; ++i) { const int sp = sq0 - 1 + i; const bool ok = (sp >= 0) && (sp < SEQ);
                    uv[i] = NT_LD((const v4u*)(PROJ + (size_t)(ok ? t0 - 1 + i : t0) * DIN + OCC + ch)); }
#pragma unroll
                for (int i = 0; i < 8; ++i) cbv[i] = NT_LD((const v4u*)(PROJ + (size_t)(t0 + i) * DIN + OCB + ch));
                float um[8], uc[8], un[8];
                auto mk_u = [&](int i, float (&uu)[8]) { const v4u a = uv[i]; const int sp = sq0 - 1 + i; const float okf = ((sp >= 0) && (sp < SEQ)) ? 1.f : 0.f;
                    uu[0] = bflo(a.x) * okf; uu[1] = bfhi(a.x) * okf; uu[2] = bflo(a.y) * okf; uu[3] = bfhi(a.y) * okf;
                    uu[4] = bflo(a.z) * okf; uu[5] = bfhi(a.z) * okf; uu[6] = bflo(a.w) * okf; uu[7] = bfhi(a.w) * okf; };
                mk_u(0, um); mk_u(1, uc);
#pragma unroll
                for (int i = 0; i < 8; ++i) {
                    mk_u(i + 2, un);
                    const v4u cb = cbv[i];
                    float y[8];
#pragma unroll
                    for (int j = 0; j < 8; ++j) y[j] = w0[j] * um[j] + w1[j] * uc[j] + w2[j] * un[j];
                    y[0] *= bflo(cb.x); y[1] *= bfhi(cb.x); y[2] *= bflo(cb.y); y[3] *= bfhi(cb.y); y[4] *= bflo(cb.z); y[5] *= bfhi(cb.z); y[6] *= bflo(cb.w); y[7] *= bfhi(cb.w);
                    v4u w; w.x = pk2(y[0], y[1]); w.y = pk2(y[2], y[3]); w.z = pk2(y[4], y[5]); w.w = pk2(y[6], y[7]);
                    *(v4u*)(CONV + (size_t)(t0 + i) * DM + ch) = w;
#pragma unroll
                    for (int j = 0; j < 8; ++j) { um[j] = uc[j]; uc[j] = un[j]; }
                }
            }
        }
        STEP_END
        STEP_BEGIN(3)
        {
            { pg8::Gemm g{WSP(unsigned char*, WS_ATT8), WSP(unsigned char*, WS_WAO8), DM, DM, DM / 128}; pg8::StaticOrderT<TC / 256, DM / 256> S; S.init(G, bx);
              EpiPlain E{(bf16*)OUT_() + (size_t)T * DM};
              pg8::gemm_phase<EpiPlain, pg8::StaticOrderT<TC / 256, DM / 256>, true, true>(lds, g, S, E); }
            { pg8::Gemm g{(const bf16*)OUT_(), WSP(bf16*, WS_WAC) + DM, 2 * DM, 4 * DM, DM / 64}; pg8::StaticOrderT<TC / 256, DM / 256> S; S.init(G, bx);
              EpiGate2 E{WSP(const bf16*, WS_PROJ), (bf16*)OUT_() + (size_t)T * DM};
              pg8::gemm_phase<EpiGate2, pg8::StaticOrderT<TC / 256, DM / 256>, true>(lds, g, S, E); }
        }
        STEP_END
    }

    STEP_BEGIN(4)
    {
        pg8::Gemm g{(const bf16*)OUT_() + (size_t)T * DM, WSP(bf16*, WS_WOUT), DM * 2, DM * 2, DM / 64}; pg8::StaticOrderT<TC / 256, DM / 256> S; S.init(G, bx);
        EpiResid E{WSP(bf16*, WS_PROJ), (NCHUNK - 1) * TC};
        pg8::gemm_phase<EpiResid, pg8::StaticOrderT<TC / 256, DM / 256>, true>(lds, g, S, E);
    }
    STEP_END

    STEP_BEGIN(5)
    {
        LAS float* wr_l = (LAS float*)lds;
        { const float* w_router = IN_(11);
          for (int i = tid; i < DM * NE; i += NWAVES * 64) { const int k = i >> 4, e = i & 15; wr_l[e * DM + k] = w_router[i]; } }
        __syncthreads();
        const float* ln1_g = IN_(9); const float* ln1_b = IN_(10); const bf16* yb = WSP(const bf16*, WS_PROJ); bf16* XN = WSP(bf16*, WS_XN); float* aff = WSP(float*, WS_AFF); unsigned char* X8 = WSP(unsigned char*, WS_XN8);
        f32x4 gv[4], bv[4];
#pragma unroll
        for (int j = 0; j < 4; ++j) { gv[j] = *(const f32x4*)(ln1_g + 4 * lane + 256 * j); bv[j] = *(const f32x4*)(ln1_b + 4 * lane + 256 * j); }
        const bool h32 = (lane & 32) != 0, h16 = (lane & 16) != 0, h8 = (lane & 8) != 0, h4 = (lane & 4) != 0, h2 = (lane & 2) != 0;
        auto logits_out = [&](float (&w16)[16], int mrow) {
            float w8[8], w4[4], w2[2];
#pragma unroll
            for (int i = 0; i < 8; ++i) w8[i] = (h16 ? w16[8 + i] : w16[i]) + __shfl_xor(h16 ? w16[i] : w16[8 + i], 16);
#pragma unroll
            for (int i = 0; i < 4; ++i) w4[i] = (h8 ? w8[4 + i] : w8[i]) + __shfl_xor(h8 ? w8[i] : w8[4 + i], 8);
#pragma unroll
            for (int i = 0; i < 2; ++i) w2[i] = (h4 ? w4[2 + i] : w4[i]) + __shfl_xor(h4 ? w4[i] : w4[2 + i], 4);
            float lg = (h2 ? w2[1] : w2[0]) + __shfl_xor(h2 ? w2[0] : w2[1], 2);
            lg += __shfl_xor(lg, 1);
            float mx = lg;
#pragma unroll
            for (int o = 2; o < 32; o <<= 1) mx = fmaxf(mx, __shfl_xor(mx, o));
            const float ex = expf(lg - mx); float den = ex;
#pragma unroll
            for (int o = 2; o < 32; o <<= 1) den += __shfl_xor(den, o);
            if ((lane & 1) == 0) aff[(size_t)(mrow + (lane >> 5)) * NE + ((lane >> 1) & 15)] = ex / den; };
        for (int m0 = 4 * gw; m0 < T; m0 += 4 * NGW) {
            f32x4 v[4][4];
#pragma unroll
            for (int r = 0; r < 4; ++r) { const v2u* yr = (const v2u*)(yb + (size_t)(m0 + r) * DM) + lane; const v2u* xr = (const v2u*)(XN + (size_t)(m0 + r) * DM) + lane;
                v2u wy[4], wx[4];
#pragma unroll
                for (int j = 0; j < 4; ++j) { wy[j] = NT_LD(yr + 64 * j); wx[j] = NT_LD(xr + 64 * j); }
#pragma unroll
                for (int j = 0; j < 4; ++j) v[r][j] = (f32x4){bflo(wx[j].x), bfhi(wx[j].x), bflo(wx[j].y), bfhi(wx[j].y)} * ALPHA + (f32x4){bflo(wy[j].x), bfhi(wy[j].x), bflo(wy[j].y), bfhi(wy[j].y)}; }
#pragma unroll
            for (int r = 0; r < 4; ++r) { float sm = 0.f;
#pragma unroll
                for (int j = 0; j < 4; ++j) sm += (v[r][j].x + v[r][j].y) + (v[r][j].z + v[r][j].w);
                const float mean = wave_sum(sm) * (1.f / DM); float s2 = 0.f;
#pragma unroll
                for (int j = 0; j < 4; ++j) { v[r][j] = v[r][j] - mean; s2 += (v[r][j].x * v[r][j].x + v[r][j].y * v[r][j].y) + (v[r][j].z * v[r][j].z + v[r][j].w * v[r][j].w); }
                const float rstd = 1.f / sqrtf(wave_sum(s2) * (1.f / DM) + LN_EPS);
                v2u* o8 = (v2u*)(XN + (size_t)(m0 + r) * DM) + lane;
#pragma unroll
                for (int j = 0; j < 4; ++j) { v[r][j] = v[r][j] * rstd * gv[j] + bv[j]; v2u w; w.x = pk2(v[r][j].x, v[r][j].y); w.y = pk2(v[r][j].z, v[r][j].w); o8[64 * j] = w;
                    ((unsigned*)(X8 + (size_t)(m0 + r) * DM))[lane + 64 * j] = pk4_fp8(v[r][j].x, v[r][j].y, v[r][j].z, v[r][j].w); } }
            float wA[16], wB[16];
#pragma unroll
            for (int e = 0; e < NE; ++e) { f32x2 p0 = {0.f, 0.f}, p1 = p0, p2 = p0, p3 = p0;
#pragma unroll
                for (int j = 0; j < 4; ++j) { const f32x4 wv = *(const LAS f32x4*)(wr_l + e * DM + 4 * lane + 256 * j);
#pragma unroll
                    for (int h = 0; h < 2; ++h) { const f32x2 wp = {wv[2 * h], wv[2 * h + 1]};
                        p0 = __builtin_elementwise_fma((f32x2){v[0][j][2 * h], v[0][j][2 * h + 1]}, wp, p0); p1 = __builtin_elementwise_fma((f32x2){v[1][j][2 * h], v[1][j][2 * h + 1]}, wp, p1);
                        p2 = __builtin_elementwise_fma((f32x2){v[2][j][2 * h], v[2][j][2 * h + 1]}, wp, p2); p3 = __builtin_elementwise_fma((f32x2){v[3][j][2 * h], v[3][j][2 * h + 1]}, wp, p3); } }
                const float a0 = p0.x + p0.y, a1 = p1.x + p1.y, a2 = p2.x + p2.y, a3 = p3.x + p3.y;
                wA[e] = (h32 ? a1 : a0) + __shfl_xor(h32 ? a0 : a1, 32);
                wB[e] = (h32 ? a3 : a2) + __shfl_xor(h32 ? a2 : a3, 32);
                if (e & 1) asm volatile("" ::: "memory"); }
            logits_out(wA, m0); logits_out(wB, m0 + 2);
        }
    }
    STEP_END

    STEP_BEGIN(6)
    {
        if (wave < 2) {
            const float* aff = WSP(const float*, WS_AFF); float* topval = WSP(float*, WS_TOPVAL); short* inv = WSP(short*, WS_INV); int* tokidx = WSP(int*, WS_TOKIDX);
            for (int u = vcu * 2 + wave; u < BATCH * NE; u += G * 2) {
                const int b = u >> 4, e = u & 15;
                unsigned key[32];
#pragma unroll
                for (int i = 0; i < 32; ++i) key[i] = __float_as_uint(aff[(size_t)(b * SEQ + lane + 64 * i) * NE + e]);
                unsigned thr = 0u;
                for (int bit = 30; bit >= 0; --bit) {
                    const unsigned cand = thr | (1u << bit); int cnt = 0;
#pragma unroll
                    for (int i = 0; i < 32; ++i) cnt += __popcll(__ballot(key[i] >= cand));
                    if (cnt >= CAP) thr = cand;
                }
                int ngt = 0;
#pragma unroll
                for (int i = 0; i < 32; ++i) ngt += __popcll(__ballot(key[i] > thr));
                const int need = CAP - ngt;
                int selb = 0, tieb = 0;
                const unsigned long long below = (1ull << lane) - 1ull;
                const size_t sbase = ((size_t)e * BATCH + b) * CAP;
#pragma unroll
                for (int i = 0; i < 32; ++i) {
                    const bool gt = key[i] > thr, eq = key[i] == thr;
                    const unsigned long long beq = __ballot(eq);
                    const int trank = tieb + __popcll(beq & below);
                    const bool sel = gt || (eq && trank < need);
                    const unsigned long long bsel = __ballot(sel);
                    const int cpos = selb + __popcll(bsel & below);
                    const int t = lane + 64 * i;
                    if (sel) { tokidx[sbase + cpos] = t; topval[sbase + cpos] = __uint_as_float(key[i]); }
                    inv[(size_t)(b * SEQ + t) * NE + e] = sel ? (short)cpos : (short)-1;
                    selb += __popcll(bsel); tieb += __popcll(beq);
                }
            }
        } else {
            LAS float* scr = (LAS float*)(lds + wave * 16384);
            constexpr int I_GU = (DM / 64) * (DFF / 32), I_DN = (DFF / 64) * (DM / 32), NITEMS = NE * (2 * I_GU + I_DN);
            for (int it = vcu * 6 + (wave - 2); it < NITEMS; it += G * 6) {
                const int e = it / (2 * I_GU + I_DN); int r = it - e * (2 * I_GU + I_DN);
                if (r < 2 * I_GU) { const int which = r / I_GU, q = r % I_GU, nblk = DFF / 32, kb = q / nblk, nb = q % nblk, n0 = 32 * nb;
                    const float* W = (which == 0 ? IN_(12) : IN_(13)) + (size_t)e * DM * DFF;
                    const int orow = (n0 >> 7) * 256 + ((n0 & 127) >> 5) * 64 + which * 32;
                    transpose_item8(W + (size_t)(64 * kb) * DFF + n0, DFF, WSP(unsigned char*, WS_WGU) + ((size_t)e * (2 * DFF) + orow) * DM + 64 * kb, DM, WGU_SCALE, scr, lane); continue; }
                r -= 2 * I_GU;
                { const int nblk = DM / 32, kb = r / nblk, nb = r % nblk;
                  transpose_item8(IN_(14) + (size_t)e * DFF * DM + (size_t)(64 * kb) * DM + 32 * nb, DM, WSP(unsigned char*, WS_WDN) + ((size_t)e * DM + 32 * nb) * DFF + 64 * kb, DFF, WDN_SCALE, scr, lane); }
            }
        }
    }
    STEP_END

    STEP_BEGIN(7)
    {
        pg8::Gemm g{WSP(unsigned char*, WS_XN8), WSP(unsigned char*, WS_WGU), DM, DM, DM / 128, WSP(const int*, WS_TOKIDX), TAB_OFF}; pg8::StaticOrderT<MSLOT / 256, 2 * DFF / 256, 5> S; S.init(G, bx);
        EpiSwiglu E{WSP(unsigned char*, WS_H)};
        pg8::gemm_phase<EpiSwiglu, pg8::StaticOrderT<MSLOT / 256, 2 * DFF / 256, 5>, true, true, PROBE_KREP, PROBE_EPIREP, true>(lds, g, S, E);
    }
    STEP_END
    STEP_BEGIN(8)
    {
        pg8::Gemm g{WSP(unsigned char*, WS_H), WSP(unsigned char*, WS_WDN), DFF, DFF, DFF / 128}; pg8::StaticOrderT<MSLOT / 256, DM / 256, 5> S; S.init(G, bx);
        EpiDown E{WSP(bf16*, WS_YE), WSP(const float*, WS_TOPVAL)};
        pg8::gemm_phase<EpiDown, pg8::StaticOrderT<MSLOT / 256, DM / 256, 5>, true, true, 1, 1, false, true>(lds, g, S, E);
    }
    STEP_END

    STEP_BEGIN(9)
    {
        if (PROBE_MFMA > 0) { pg8::v8i_t pa, pb; f32x4 pc0 = (f32x4){0.f, 0.f, 0.f, 0.f}, pc1 = pc0, pc2 = pc0, pc3 = pc0;
#pragma unroll
            for (int q = 0; q < 8; ++q) { pa[q] = 0x38383838 + lane; pb[q] = 0x3c3c3c3c - lane; }
#pragma unroll 1
            for (int k = 0; k < PROBE_MFMA / 4; ++k) { asm volatile("v_mfma_f32_16x16x128_f8f6f4 %0, %4, %5, %0\n\tv_mfma_f32_16x16x128_f8f6f4 %1, %4, %5, %1\n\tv_mfma_f32_16x16x128_f8f6f4 %2, %4, %5, %2\n\tv_mfma_f32_16x16x128_f8f6f4 %3, %4, %5, %3"
                : "+v"(pc0), "+v"(pc1), "+v"(pc2), "+v"(pc3) : "v"(pa), "v"(pb)); }
            asm volatile("s_nop 15\n\ts_nop 15" :: "v"(pc0), "v"(pc1), "v"(pc2), "v"(pc3)); }
        const float* ln2_g = IN_(15); const float* ln2_b = IN_(16);
        float* outp = OUT_(); const bf16* XN = WSP(const bf16*, WS_XN); const short* inv = WSP(const short*, WS_INV); const bf16* YE = WSP(const bf16*, WS_YE);
        f32x4 g2[4], b2[4];
#pragma unroll
        for (int j = 0; j < 4; ++j) { g2[j] = *(const f32x4*)(ln2_g + 4 * lane + 256 * j); b2[j] = *(const f32x4*)(ln2_b + 4 * lane + 256 * j); }
        v2u xc[4], xn_[4]; int slotc, slotn;
#pragma unroll
        for (int j = 0; j < 4; ++j) xc[j] = ((const v2u*)(XN + (size_t)gw * DM) + lane)[64 * j];
        slotc = (lane < NE) ? (int)inv[(size_t)gw * NE + lane] : -1;
        for (int m = gw; m < T; m += NGW) {
            f32x4* yr = (f32x4*)(outp + (size_t)m * DM) + lane;
            const int mn = (m + NGW < T) ? m + NGW : m;
#pragma unroll
            for (int j = 0; j < 4; ++j) xn_[j] = ((const v2u*)(XN + (size_t)mn * DM) + lane)[64 * j];
            slotn = (lane < NE) ? (int)inv[(size_t)mn * NE + lane] : -1;
            f32x4 v[4];
#pragma unroll
            for (int j = 0; j < 4; ++j) { const v2u w = xc[j]; v[j].x = bflo(w.x) * ALPHA; v[j].y = bfhi(w.x) * ALPHA; v[j].z = bflo(w.y) * ALPHA; v[j].w = bfhi(w.y) * ALPHA; }
            const int b = m >> 11;
            unsigned long long mk = __ballot(slotc >= 0);
            while (mk) {
                int ee[4], cp[4];
#pragma unroll
                for (int q = 0; q < 4; ++q) { ee[q] = -1; cp[q] = 0; if (mk) { ee[q] = __ffsll((long long)mk) - 1; mk &= mk - 1; cp[q] = __builtin_amdgcn_readlane(slotc, ee[q]); } }
                v2u w4[4][4];
#pragma unroll
                for (int q = 0; q < 4; ++q) if (ee[q] >= 0) { const v2u* yp = (const v2u*)(YE + ((size_t)(ee[q] * BATCH + b) * CAP + cp[q]) * DM) + lane;
#pragma unroll
                    for (int j = 0; j < 4; ++j) w4[q][j] = NT_LD(yp + 64 * j); }
#pragma unroll
                for (int q = 0; q < 4; ++q) if (ee[q] >= 0) {
#pragma unroll
                    for (int j = 0; j < 4; ++j) { const v2u w = w4[q][j]; v[j].x += bflo(w.x); v[j].y += bfhi(w.x); v[j].z += bflo(w.y); v[j].w += bfhi(w.y); } }
            }
            float sm = 0.f;
#pragma unroll
            for (int j = 0; j < 4; ++j) sm += (v[j].x + v[j].y) + (v[j].z + v[j].w);
            const float mean = wave_sum(sm) * (1.f / DM); float s2 = 0.f;
#pragma unroll
            for (int j = 0; j < 4; ++j) { v[j] = v[j] - mean; s2 += (v[j].x * v[j].x + v[j].y * v[j].y) + (v[j].z * v[j].z + v[j].w * v[j].w); }
            const float rstd = 1.f / sqrtf(wave_sum(s2) * (1.f / DM) + LN_EPS);
#pragma unroll
            for (int j = 0; j < 4; ++j) NT_ST(yr + 64 * j, v[j] * rstd * g2[j] + b2[j]);
#pragma unroll
            for (int j = 0; j < 4; ++j) xc[j] = xn_[j];
            slotc = slotn;
        }
    }
    STEP_END
#undef STEP_BEGIN
#undef STEP_END
}

constexpr int NSTEPS = 1 + NCHUNK * 3 + 1 + 2 + 2 + 1;

extern "C" void kernel_launch(void* const* d_in, const int* in_sizes, int n_in, void* d_out, int out_size, void* d_ws, size_t ws_size, hipStream_t stream) {
    static int grid = 0;
    if (grid == 0) {
        if (n_in != 17 || in_sizes[0] != T * DM || out_size != T * DM || ws_size < WS_END) { fprintf(stderr, "kernel_launch: unexpected shapes / workspace (%zu < %zu); nothing launched\n", ws_size, (size_t)WS_END); grid = -1; return; }
        int dev = 0, cus = 0, per_cu = 0;
        if (hipGetDevice(&dev) != hipSuccess || hipDeviceGetAttribute(&cus, hipDeviceAttributeMultiprocessorCount, dev) != hipSuccess) { grid = -1; return; }
        if (hipFuncSetAttribute((const void*)hybrid_fwd, hipFuncAttributeMaxDynamicSharedMemorySize, LDS_BYTES) != hipSuccess) { fprintf(stderr, "kernel_launch: hipFuncSetAttribute failed\n"); grid = -1; return; }
        if (hipOccupancyMaxActiveBlocksPerMultiprocessor(&per_cu, (const void*)hybrid_fwd, NWAVES * 64, LDS_BYTES) != hipSuccess || per_cu < 1)
            fprintf(stderr, "kernel_launch: occupancy query reports %d workgroups per CU\n", per_cu);
        (void)hipGetLastError();
        grid = cus;
    }
    if (grid < 0) return;
    (void)hipMemsetAsync((char*)d_ws + WS_CTL, 0, CTL_ZERO_BYTES, stream);
    Args a{};
    for (int i = 0; i < 17; ++i) a.in[i] = (const float*)d_in[i];
    a.out = (float*)d_out; a.ws = (unsigned char*)d_ws;
#if ONE_LAUNCH
    a.lo = 0; a.hi = NSTEPS;
    hipLaunchKernelGGL(hybrid_fwd, dim3(grid), dim3(NWAVES * 64), LDS_BYTES, stream, a);
#else
    for (int st = 0; st < NSTEPS; ++st) { a.lo = st; a.hi = st + 1; hipLaunchKernelGGL(hybrid_fwd, dim3(grid), dim3(NWAVES * 64), LDS_BYTES, stream, a); }
#endif
}
```

```cpp
#include <hip/hip_runtime.h>
#include <type_traits>
#include <cstdio>
#include <cstdint>

#ifndef REPEAT_MASK
#define REPEAT_MASK 0
#endif
#ifndef PROBE_KREP
#define PROBE_KREP 1
#endif
#ifndef PROBE_NOISE
#define PROBE_NOISE 0
#endif
#ifndef PROBE_EPIREP
#define PROBE_EPIREP 1
#endif
#ifndef PROBE_MFMA
#define PROBE_MFMA 0
#endif
#ifndef ONE_LAUNCH
#define ONE_LAUNCH 1
#endif

namespace pg8 {
#define PG8_LAS __attribute__((address_space(3)))
typedef unsigned short bf16_t;
typedef short bf16x8 __attribute__((ext_vector_type(8)));
typedef float f32x4 __attribute__((ext_vector_type(4)));
typedef unsigned u32x4 __attribute__((ext_vector_type(4)));
constexpr int BM = 256, BK = 64, HALF = 128, HTB = HALF * BK * 2  , STAGE_BYTES = 8 * HTB, NXCD = 8, WGM = 8;

__host__ __device__ __forceinline__ int lds_byte(int r, int c) { const int st = (r >> 4) * 2 + (c >> 5), rr = r & 15, cc = c & 31, ob = rr * 64 + cc * 2; return st * 1024 + (ob ^ (((ob >> 9) & 1) << 5)); }
__host__ __device__ __forceinline__ void stage_rc(int b, int& R, int& C) { const int st = b / 1024, sb = b % 1024, swz = sb ^ (((sb >> 9) & 1) << 5); R = (st >> 1) * 16 + swz / 64; C = (st & 1) * 32 + (swz % 64) / 2; }
__host__ __device__ __forceinline__ int perm32(int rho) { const int n = rho >> 4, i = rho & 15; return 8 * (i >> 2) + 4 * n + (i & 3); }

struct Unit { int pm, pn, pb; };
struct Gemm { const void* A; const void* Bt; int lda, ldb, nt; const int* gtok; int tab_off; };

struct StaticOrder {
    int nM, nN, nwg, G, c, gshift, pb0;
    __device__ void init(int M, int N, int G_, int c_, int gshift_ = 30, int pb0_ = 0) { nM = M / BM; nN = N / BM; nwg = nM * nN; G = G_; c = c_; gshift = gshift_; pb0 = pb0_; }
    __device__ bool next(int i, Unit& u) const {
        const long L = (long)i * G + c; if (L >= nwg) return false;
        int wgid = (int)L; { const int q = nwg / NXCD, r = nwg % NXCD, xcd = wgid % NXCD, off = wgid / NXCD; wgid = (xcd < r ? xcd * (q + 1) : r * (q + 1) + (xcd - r) * q) + off; }
        const int nig = WGM * nN, gid = wgid / nig, fm = gid * WGM, gsz = (nM - fm) < WGM ? (nM - fm) : WGM;
        u.pm = fm + ((wgid % nig) % gsz); u.pn = (wgid % nig) / gsz; u.pb = (u.pm >> gshift) * nN + pb0 + u.pn; return true;
    }
};

template <int NM, int NN, int GSHIFT = 30> struct StaticOrderT {
    int G, c;
    __device__ void init(int G_, int c_) { G = G_; c = c_; }
    __device__ bool next(int i, Unit& u) const {
        static_assert(NM % WGM == 0 && (NM * NN) % NXCD == 0, "StaticOrderT shapes");
        constexpr int nwg = NM * NN, q = nwg / NXCD, nig = WGM * NN;
        const int L = i * G + c; if (L >= nwg) return false;
        const int wgid = (L % NXCD) * q + L / NXCD, w = wgid % nig;
        u.pm = (wgid / nig) * WGM + (w % WGM); u.pn = w / WGM; u.pb = (u.pm >> GSHIFT) * NN + u.pn; return true;
    }
};

__device__ __forceinline__ unsigned cvt_pk_bf16(float lo, float hi) { unsigned r; asm volatile("v_cvt_pk_bf16_f32 %0, %1, %2" : "=v"(r) : "v"(lo), "v"(hi)); return r; }

typedef int v8i_t __attribute__((ext_vector_type(8))); typedef int v4i_t __attribute__((ext_vector_type(4)));
__device__ __forceinline__ v8i_t cat8(bf16x8 lo, bf16x8 hi) { return __builtin_shufflevector(__builtin_bit_cast(v4i_t, lo), __builtin_bit_cast(v4i_t, hi), 0, 1, 2, 3, 4, 5, 6, 7); }
template <class Epi, class Sched, bool ALIGN_EPI = false, bool FP8 = false, int KREP = 1, int EPIREP = 1, bool AG = false, bool AT = false>
__device__ __forceinline__ void gemm_phase(PG8_LAS unsigned char* lds, const Gemm g, const Sched& S, const Epi& E) {
    int tid_ = threadIdx.x; asm volatile("" : "+v"(tid_));
    const int tid = tid_, wid = __builtin_amdgcn_readfirstlane(tid >> 6), lane = tid & 63, wr = wid >> 2, wc = wid & 3, fr = lane & 15, fq = lane >> 4;
    const int nt = g.nt;
    unsigned voffA[2], voffB[2]; int rowA[2], colA[2];
#pragma unroll
    for (int i = 0; i < 2; ++i) { int R, C; stage_rc(tid * 16 + i * 8192, R, C); const int Rb = 64 * (R >> 5) + (Epi::PERM ? perm32(R & 31) : (R & 31));
        voffA[i] = AT ? (unsigned)((R >> 4) * 16 * g.lda + (R & 15) * 32 + ((C * 2) >> 5) * 512 + ((C * 2) & 31)) : (unsigned)(R * g.lda + C * 2); voffB[i] = (unsigned)(Rb * g.ldb + C * 2); rowA[i] = R; colA[i] = C * 2; }
    const __amdgpu_buffer_rsrc_t rsA = __builtin_amdgcn_make_buffer_rsrc((void*)g.A, 0, -1, 0x00020000), rsB = __builtin_amdgcn_make_buffer_rsrc((void*)g.Bt, 0, -1, 0x00020000);
    const unsigned kstep = (unsigned)(BK * 2), kstepA = AT ? 2048u : kstep;
    const unsigned hstepA = AG ? 0u : (unsigned)(HALF * g.lda), hstepB = (unsigned)(32 * g.ldb);
    const unsigned tstepA = 2u * hstepA, tstepB = (unsigned)(BM * g.ldb);
    const unsigned ldsw = (unsigned)wid * 1024u;
    const int aoff = lds_byte(wr * 64 + fr, fq * 8), boff = lds_byte(wc * 32 + fr, fq * 8);
#define PG8_SA(b, h) (((b) * 2 + (h)) * HTB)
#define PG8_SB(b, h) ((4 + (b) * 2 + (h)) * HTB)
#define PG8_STAGE(bufoff, rs, soff, voff) do { _Pragma("unroll") for (int _i = 0; _i < 2; ++_i) \
        __builtin_amdgcn_raw_ptr_buffer_load_lds(rs, (PG8_LAS unsigned*)(lds + (bufoff) + ldsw + _i * 8192), 16, (int)(voff)[_i], (int)(soff), 0, 0); } while (0)
#define PG8_LDF(base) cat8(*(const PG8_LAS bf16x8*)(lds + (base)), *(const PG8_LAS bf16x8*)(lds + (base) + 1024))
#define PG8_LDA(dst, b, h) do { _Pragma("unroll") for (int m = 0; m < 4; ++m) dst[m] = PG8_LDF(PG8_SA(b, h) + aoff + m * 2048); } while (0)
#define PG8_LDB(dst, b, h) do { _Pragma("unroll") for (int n = 0; n < 2; ++n) dst[n] = PG8_LDF(PG8_SB(b, h) + boff + n * 2048); } while (0)
#define PG8_LO(f) __builtin_bit_cast(bf16x8, __builtin_shufflevector(f, f, 0, 1, 2, 3))
#define PG8_HI(f) __builtin_bit_cast(bf16x8, __builtin_shufflevector(f, f, 4, 5, 6, 7))
#define PG8_MMA(ai, bj, At, Bt) do { __builtin_amdgcn_s_setprio(1);   \
        if constexpr (FP8) { _Pragma("unroll") for (int m = 0; m < 4; ++m) _Pragma("unroll") for (int n = 0; n < 2; ++n) \
            asm volatile("v_mfma_f32_16x16x128_f8f6f4 %0, %1, %2, %0" : "+v"(acc[ai][bj][m][n]) : "v"(Bt[n]), "v"(At[m])); } \
        else if constexpr (Epi::ASM_BF16) {   \
            _Pragma("unroll") for (int m = 0; m < 4; m += 2) { \
                _Pragma("unroll") for (int mm = m; mm < m + 2; ++mm) _Pragma("unroll") for (int n = 0; n < 2; ++n) \
                    asm volatile("v_mfma_f32_16x16x32_bf16 %0, %1, %2, %0" : "+v"(acc[ai][bj][mm][n]) : "v"(PG8_LO(Bt[n])), "v"(PG8_LO(At[mm]))); \
                _Pragma("unroll") for (int mm = m; mm < m + 2; ++mm) _Pragma("unroll") for (int n = 0; n < 2; ++n) \
                    asm volatile("v_mfma_f32_16x16x32_bf16 %0, %1, %2, %0" : "+v"(acc[ai][bj][mm][n]) : "v"(PG8_HI(Bt[n])), "v"(PG8_HI(At[mm]))); } } \
        else { _Pragma("unroll") for (int m = 0; m < 4; ++m) _Pragma("unroll") for (int n = 0; n < 2; ++n) { \
               acc[ai][bj][m][n] = __builtin_amdgcn_mfma_f32_16x16x32_bf16(PG8_LO(Bt[n]), PG8_LO(At[m]), acc[ai][bj][m][n], 0, 0, 0); \
               acc[ai][bj][m][n] = __builtin_amdgcn_mfma_f32_16x16x32_bf16(PG8_HI(Bt[n]), PG8_HI(At[m]), acc[ai][bj][m][n], 0, 0, 0); } } \
        __builtin_amdgcn_s_setprio(0); } while (0)
#define PG8_MMAZ(ai, bj, At, Bt) do { __builtin_amdgcn_s_setprio(1);   \
        _Pragma("unroll") for (int m = 0; m < 4; ++m) _Pragma("unroll") for (int n = 0; n < 2; ++n) { \
            if constexpr (FP8) asm volatile("v_mfma_f32_16x16x128_f8f6f4 %0, %1, %2, 0" : "=&v"(acc[ai][bj][m][n]) : "v"(Bt[n]), "v"(At[m])); \
            else asm volatile("v_mfma_f32_16x16x32_bf16 %0, %1, %2, 0" : "=&v"(acc[ai][bj][m][n]) : "v"(PG8_LO(Bt[n])), "v"(PG8_LO(At[m]))); } \
        if constexpr (!FP8) { if constexpr (Epi::ASM_BF16) { _Pragma("unroll") for (int m = 0; m < 4; ++m) _Pragma("unroll") for (int n = 0; n < 2; ++n) \
                asm volatile("v_mfma_f32_16x16x32_bf16 %0, %1, %2, %0" : "+v"(acc[ai][bj][m][n]) : "v"(PG8_HI(Bt[n])), "v"(PG8_HI(At[m]))); } \
            else { asm volatile("s_nop 7" ::: "memory"); _Pragma("unroll") for (int m = 0; m < 4; ++m) _Pragma("unroll") for (int n = 0; n < 2; ++n) \
                acc[ai][bj][m][n] = __builtin_amdgcn_mfma_f32_16x16x32_bf16(PG8_HI(Bt[n]), PG8_HI(At[m]), acc[ai][bj][m][n], 0, 0, 0); } } \
        __builtin_amdgcn_s_setprio(0); } while (0)
#define PG8_WAIT_V(n) asm volatile("s_waitcnt vmcnt(" #n ")" ::: "memory")
#define PG8_WAIT_V8(relaxed) do { if (relaxed) asm volatile("s_waitcnt vmcnt(%0)" :: "n"(8 + Epi::NST) : "memory"); else asm volatile("s_waitcnt vmcnt(8)" ::: "memory"); } while (0)
#define PG8_WAIT_L(n) asm volatile("s_waitcnt lgkmcnt(" #n ")" ::: "memory")
#define PG8_BAR __builtin_amdgcn_s_barrier()
#define PG8_SCHED __builtin_amdgcn_sched_barrier(0)
    Unit cur, nxt; int ui = 0;
    if (!S.next(0, cur)) return;
    PG8_LAS unsigned short* tab = (PG8_LAS unsigned short*)(lds + g.tab_off);
    if constexpr (AG) {
        int nu = 1; { Unit uu; while (S.next(nu, uu)) ++nu; }
        for (int idx = tid; idx < nu * 256; idx += 512) { Unit uu; S.next(idx >> 8, uu); tab[idx] = (unsigned short)g.gtok[uu.pm * 256 + (idx & 255)]; }
        asm volatile("s_waitcnt vmcnt(0) lgkmcnt(0)" ::: "memory"); __builtin_amdgcn_s_barrier(); asm volatile("" ::: "memory");
    }
    unsigned cvA[2][2], nvA[2][2];
#pragma unroll
    for (int h = 0; h < 2; ++h)
#pragma unroll
        for (int i = 0; i < 2; ++i) { cvA[h][i] = AG ? ((unsigned)((cur.pm & 31) * 2048) + (unsigned)tab[128 * h + rowA[i]]) * (unsigned)g.lda + (unsigned)colA[i] : voffA[i]; nvA[h][i] = cvA[h][i]; }
    f32x4 acc[2][2][4][2];
#pragma unroll
    for (int a = 0; a < 2; ++a)
#pragma unroll
        for (int b = 0; b < 2; ++b)
#pragma unroll
            for (int m = 0; m < 4; ++m)
#pragma unroll
                for (int n = 0; n < 2; ++n) acc[a][b][m][n] = (f32x4){0.f, 0.f, 0.f, 0.f};
    v8i_t At[4], B0[2], B1[2];
    unsigned cA = AG ? 0u : (unsigned)cur.pm * tstepA, cB = (unsigned)cur.pb * tstepB;
    PG8_STAGE(PG8_SB(0, 0), rsB, cB, voffB); PG8_STAGE(PG8_SB(0, 1), rsB, cB + hstepB, voffB); PG8_STAGE(PG8_SA(0, 0), rsA, cA, cvA[0]); PG8_STAGE(PG8_SA(0, 1), rsA, cA + hstepA, cvA[1]);
    if (wr == 1) PG8_BAR;
    PG8_WAIT_V(2); PG8_BAR;
    PG8_STAGE(PG8_SB(1, 0), rsB, cB + kstep, voffB); PG8_STAGE(PG8_SA(1, 0), rsA, cA + kstepA, cvA[0]); PG8_STAGE(PG8_SB(1, 1), rsB, cB + hstepB + kstep, voffB);
    PG8_WAIT_V(6); PG8_BAR;
    for (;;) {
        const bool has_next = S.next(ui + 1, nxt);
        const unsigned nA = (has_next && !AG) ? (unsigned)nxt.pm * tstepA : cA, nB = has_next ? (unsigned)nxt.pb * tstepB : cB;
        if constexpr (AG) { if (has_next) {
#pragma unroll
            for (int h = 0; h < 2; ++h)
#pragma unroll
                for (int i = 0; i < 2; ++i) nvA[h][i] = ((unsigned)((nxt.pm & 31) * 2048) + (unsigned)tab[(ui + 1) * 256 + 128 * h + rowA[i]]) * (unsigned)g.lda + (unsigned)colA[i]; } }
        auto trip = [&](auto ztag, const int t) __attribute__((always_inline)) {
            constexpr bool ZERO = decltype(ztag)::value;
            const bool last = (t == nt * KREP - 2), after_epi = (t == 0) && (ui > 0);
            const int t1 = (KREP > 1) ? (t + 1) % nt : t + 1, t2 = (KREP > 1) ? (t + 2) % nt : t + 2;
            const unsigned a1 = cA + (unsigned)t1 * kstepA;
            const unsigned a2 = last ? nA : cA + (unsigned)t2 * kstepA, b2 = last ? nB : cB + (unsigned)t2 * kstep;
            const unsigned a3 = a2 + kstepA, b3 = b2 + kstep;
            unsigned selA[2][2];
#pragma unroll
            for (int h = 0; h < 2; ++h)
#pragma unroll
                for (int i = 0; i < 2; ++i) selA[h][i] = (AG && last) ? nvA[h][i] : cvA[h][i];
            PG8_LDB(B0, 0, 0); PG8_LDB(B1, 0, 1); PG8_SCHED; PG8_LDA(At, 0, 0); PG8_STAGE(PG8_SA(1, 1), rsA, a1 + hstepA, cvA[1]);
            PG8_WAIT_V8(after_epi); PG8_WAIT_L(0); PG8_BAR; if constexpr (ZERO) { PG8_MMAZ(0, 0, At, B0); PG8_MMAZ(0, 1, At, B1); } else { PG8_MMA(0, 0, At, B0); PG8_MMA(0, 1, At, B1); } PG8_BAR; PG8_SCHED;
            PG8_LDA(At, 0, 1); PG8_STAGE(PG8_SB(0, 0), rsB, b2, voffB); PG8_STAGE(PG8_SB(0, 1), rsB, b2 + hstepB, voffB); PG8_STAGE(PG8_SA(0, 0), rsA, a2, selA[0]);
            PG8_WAIT_V8(after_epi); PG8_WAIT_L(0); PG8_BAR; if constexpr (ZERO) { PG8_MMAZ(1, 0, At, B0); PG8_MMAZ(1, 1, At, B1); } else { PG8_MMA(1, 0, At, B0); PG8_MMA(1, 1, At, B1); } PG8_BAR; PG8_SCHED;
            PG8_LDB(B0, 1, 0); PG8_LDB(B1, 1, 1); PG8_SCHED; PG8_LDA(At, 1, 0); PG8_STAGE(PG8_SA(0, 1), rsA, a2 + hstepA, selA[1]);
            PG8_WAIT_V(8); PG8_WAIT_L(0); PG8_BAR; PG8_MMA(0, 0, At, B0); PG8_MMA(0, 1, At, B1); PG8_BAR; PG8_SCHED;
            PG8_LDA(At, 1, 1); PG8_STAGE(PG8_SB(1, 0), rsB, b3, voffB); PG8_STAGE(PG8_SB(1, 1), rsB, b3 + hstepB, voffB); PG8_STAGE(PG8_SA(1, 0), rsA, a3, selA[0]);
            PG8_WAIT_V(8); PG8_WAIT_L(0); PG8_BAR; PG8_MMA(1, 0, At, B0); PG8_MMA(1, 1, At, B1); PG8_BAR; PG8_SCHED;
                };
        if constexpr (KREP == 1) {
            trip(std::true_type{}, 0);
#pragma unroll 1
            for (int t = 2; t < nt; t += 2) trip(std::false_type{}, t);
        } else {
#pragma unroll 1
            for (int t = 0; t < nt * KREP; t += 2) trip(std::false_type{}, t);
        }
        if constexpr (FP8 || Epi::ASM_BF16) asm volatile("s_nop 15\n\ts_nop 15" ::: "memory");
        if constexpr (ALIGN_EPI) { if (wr == 0) PG8_BAR; }
        E(acc, cur, wr, wc, fr, fq);
        if constexpr (EPIREP > 1) { asm volatile("" ::: "memory"); E(acc, cur, wr, wc, fr, fq); }
        if (!has_next) break;
        if constexpr (KREP > 1) {
#pragma unroll
        for (int a = 0; a < 2; ++a)
#pragma unroll
            for (int b = 0; b < 2; ++b)
#pragma unroll
                for (int m = 0; m < 4; ++m)
#pragma unroll
                    for (int n = 0; n < 2; ++n) acc[a][b][m][n] = (f32x4){0.f, 0.f, 0.f, 0.f}; }
        cur = nxt; cA = nA; cB = nB; ++ui;
#pragma unroll
        for (int h = 0; h < 2; ++h)
#pragma unroll
            for (int i = 0; i < 2; ++i) cvA[h][i] = nvA[h][i];
        if constexpr (ALIGN_EPI) { if (wr == 1) PG8_BAR; }
    }
    PG8_WAIT_V(0);
    if constexpr (!ALIGN_EPI) { if (wr == 0) PG8_BAR; }
    PG8_BAR;
#undef PG8_SA
#undef PG8_SB
#undef PG8_STAGE
#undef PG8_LDA
#undef PG8_LDB
#undef PG8_LDF
#undef PG8_LO
#undef PG8_HI
#undef PG8_MMA
#undef PG8_WAIT_V
#undef PG8_WAIT_V8
#undef PG8_WAIT_L
#undef PG8_BAR
#undef PG8_SCHED
}
}

constexpr int NWAVES = 8;
constexpr int BATCH = 32, SEQ = 2048, DM = 1024, T = BATCH * SEQ, SRC_DIN = 6656, DIN = 5632;
constexpr int NE = 16, CAP = 256, DFF = 2048;
constexpr int S_CB = 1536, S_CC = 2560, S_CX = 3584, S_GA = 4608;
constexpr int OQ = 0, OK_ = 1024, OV = 1280, OCB = 1536, OCC = 2560, OGA = 3584, OGC = 4608;
constexpr int NCHUNK = 1, CBATCH = BATCH / NCHUNK, TC = CBATCH * SEQ;
constexpr int MSLOT = NE * BATCH * CAP;
constexpr float ATT_SCALE = 8.f, WAO_SCALE = 32.f;
constexpr float WIN_SCALE = 32.f, WGU_SCALE = 32.f, WDN_SCALE = 64.f, H_SCALE = 8.f;
constexpr float LN_EPS = 1e-5f, ALPHA = 1.189207115002721f, LOG2E = 1.4426950408889634f;
constexpr float ATT_THR = 8.0f;
constexpr float QSCALE = 0.125f * LOG2E;

constexpr size_t MiB = 1u << 20;
constexpr size_t WS_CTL = 0, CTL_ZERO_BYTES = 64 * 1024;
constexpr size_t WS_STATS0 = 1 * MiB;
constexpr size_t WS_STATS1 = WS_STATS0 + 512 * 1024;
constexpr size_t WS_TOKIDX = 2 * MiB;
constexpr size_t WS_TOPVAL = WS_TOKIDX + 512 * 1024;
constexpr size_t WS_INV = 3 * MiB;
constexpr size_t WS_AFF = 5 * MiB;
constexpr size_t WS_WIN8 = 9 * MiB;
constexpr size_t WS_WINC = 14 * MiB;
constexpr int NF8 = 4608, NCV = 2048, NGAT = 3072;
constexpr size_t WS_WAC = 22 * MiB;
constexpr size_t WS_WOUT = 26 * MiB;
constexpr size_t WS_XN = 32 * MiB;
constexpr size_t WS_XN8 = 160 * MiB;
constexpr size_t WS_PROJ = 224 * MiB;
constexpr size_t WS_TMP = WS_XN, WS_ATT8 = WS_XN8;
constexpr size_t WS_WAO8 = 28 * MiB;
constexpr size_t WS_WGU = 224 * MiB;
constexpr size_t WS_WDN = 288 * MiB;
constexpr size_t WS_H = 320 * MiB;
constexpr size_t WS_YE = 576 * MiB;
constexpr size_t WS_END = 928 * MiB;
static_assert(WS_PROJ + (size_t)T * DIN * 2 <= WS_END && WS_YE + (size_t)MSLOT * DM * 2 <= WS_END && WS_H + (size_t)MSLOT * DFF <= WS_YE, "ws map");
static_assert(WS_XN + (size_t)T * DM * 2 <= WS_XN8 && WS_XN8 + (size_t)T * DM <= WS_PROJ && WS_WDN + (size_t)NE * DM * DFF <= WS_H && WS_WGU + (size_t)NE * 2 * DFF * DM <= WS_WDN, "ws map");

constexpr int CW_BAR = 4096;
constexpr int RING_BYTES = 131072, MISC_OFF = RING_BYTES + 320, TAB_OFF = RING_BYTES + 1024  , LDS_BYTES = 155648;

#define GAS __attribute__((address_space(1)))
#define LAS __attribute__((address_space(3)))
typedef unsigned short bf16;
typedef unsigned v4u __attribute__((ext_vector_type(4)));
typedef unsigned v2u __attribute__((ext_vector_type(2)));
typedef float f32x4 __attribute__((ext_vector_type(4)));
typedef float f32x2 __attribute__((ext_vector_type(2)));
typedef float f32x16 __attribute__((ext_vector_type(16)));
typedef short bf16x8 __attribute__((ext_vector_type(8)));
typedef short s16x4 __attribute__((ext_vector_type(4)));
#define LDS_WAIT() asm volatile("s_waitcnt lgkmcnt(0)" ::: "memory")
__device__ __forceinline__ unsigned f2bf(float f) { unsigned u = __builtin_bit_cast(unsigned, f); return (u + 0x7fffu + ((u >> 16) & 1u)) >> 16; }
__device__ __forceinline__ unsigned pk2(float lo, float hi) { return f2bf(lo) | (f2bf(hi) << 16); }
__device__ __forceinline__ float bflo(unsigned u) { return __uint_as_float(u << 16); }
__device__ __forceinline__ float bfhi(unsigned u) { return __uint_as_float(u & 0xffff0000u); }
__device__ __forceinline__ float sigmoidf_(float x) { return __builtin_amdgcn_rcpf(1.0f + __expf(-x)); }
__device__ __forceinline__ unsigned pk4_fp8(float a, float b, float c, float d) { unsigned w = __builtin_amdgcn_cvt_pk_fp8_f32(a, b, 0u, false); return __builtin_amdgcn_cvt_pk_fp8_f32(c, d, w, true); }

#define XB_TMO      128
#define XB_XCNT(j)  (256  + 64 * (j))
#define XB_XSUB(j)  (1280 + 64 * (j))
#define XB_XGEN(j)  (2304 + 64 * (j))
#define XB_TOP      3328
#define XB_TOPGEN   3392
#define XCD_BAR_WORDS 3456
#define XB_SPIN_CAP (1u << 22)
__device__ __forceinline__ unsigned xb_ld(unsigned* p)              { return __hip_atomic_load(p, __ATOMIC_RELAXED, __HIP_MEMORY_SCOPE_AGENT); }
__device__ __forceinline__ unsigned xb_add(unsigned* p, unsigned v) { return __hip_atomic_fetch_add(p, v, __ATOMIC_RELAXED, __HIP_MEMORY_SCOPE_AGENT); }
__device__ __forceinline__ unsigned xb_xcc_id() { return (unsigned)__builtin_amdgcn_s_getreg((3 << 11) | 20) & 0xFu; }
#define XB_SPIN(cond, bar) do { unsigned _sp = 0; while (cond) { __builtin_amdgcn_s_sleep(1); \
    if ((++_sp & 255u) == 0u) { if (xb_ld(&(bar)[XB_TMO])) break; if (_sp > XB_SPIN_CAP) { atomicAdd(&(bar)[XB_TMO], 1u); break; } } } } while (0)
struct XcdBarrier { unsigned* bar; unsigned x; volatile LAS unsigned* st; };
__device__ __forceinline__ XcdBarrier xcd_barrier_post(unsigned* bar, volatile LAS unsigned* st) {
    XcdBarrier b; b.bar = bar; b.x = xb_xcc_id(); b.st = st;
    if (threadIdx.x == 0) (void)xb_add(&bar[XB_XCNT(b.x)], 1u);
    return b;
}
__device__ __forceinline__ void xcd_barrier_complete(unsigned* bar, unsigned x, unsigned& nloc, unsigned& nx) {
    const unsigned G = gridDim.x * gridDim.y * gridDim.z;
    unsigned sum, cnt, mine, sp = 0u;
    for (;;) {
        sum = 0u; cnt = 0u; mine = 0u;
#pragma unroll
        for (unsigned j = 0; j < 16; ++j) { const unsigned c = xb_ld(&bar[XB_XCNT(j)]); sum += c; cnt += (c > 0u) ? 1u : 0u; mine = (j == x) ? c : mine; }
        if (sum == G) break;
        __builtin_amdgcn_s_sleep(1);
        if ((++sp & 255u) == 0u) { if (xb_ld(&bar[XB_TMO])) break; if (sp > XB_SPIN_CAP) { atomicAdd(&bar[XB_TMO], 1u); break; } }
    }
    nloc = mine > 0u ? mine : 1u; nx = cnt > 0u ? cnt : 1u;
}
__device__ __forceinline__ void xcd_barrier(const XcdBarrier& b) {
    asm volatile("s_waitcnt vmcnt(0)" ::: "memory");
    __syncthreads();
    if (threadIdx.x == 0) {
        unsigned* bar = b.bar;
        __builtin_amdgcn_s_waitcnt(0);
        unsigned nloc = b.st[0], nx = b.st[1];
        if (nloc == 0u) { xcd_barrier_complete(bar, b.x, nloc, nx); b.st[0] = nloc; b.st[1] = nx; }
        const unsigned old = xb_add(&bar[XB_XSUB(b.x)], 1u);
        const unsigned gen = old / nloc;
        if (old + 1u == (gen + 1u) * nloc) {
            __builtin_amdgcn_fence(__ATOMIC_RELEASE, "agent");
            asm volatile("s_waitcnt vmcnt(0)" ::: "memory");
            const unsigned og = xb_add(&bar[XB_TOP], 1u);
            const unsigned tg = og / nx;
            if (og + 1u == (tg + 1u) * nx) xb_add(&bar[XB_TOPGEN], 1u);
            else XB_SPIN(xb_ld(&bar[XB_TOPGEN]) == tg, bar);
            __builtin_amdgcn_fence(__ATOMIC_ACQUIRE, "agent");
            xb_add(&bar[XB_XGEN(b.x)], 1u);
            asm volatile("s_waitcnt vmcnt(0)" ::: "memory");
        } else {
            XB_SPIN(xb_ld(&bar[XB_XGEN(b.x)]) == gen, bar);
            __builtin_amdgcn_fence(__ATOMIC_ACQUIRE, "agent");
            asm volatile("s_waitcnt vmcnt(0)" ::: "memory");
        }
    }
    __syncthreads();
}

__device__ __forceinline__ float wave_sum(float v) {
#pragma unroll
    for (int o = 1; o < 64; o <<= 1) v += __shfl_xor(v, o);
    return v;
}

using pg8::Unit; using pg8::bf16_t;
template <int BANK> __device__ __forceinline__ unsigned dpp_x8(unsigned old, unsigned src) { return (unsigned)__builtin_amdgcn_update_dpp((int)old, (int)src, 0x128  , 0xf, BANK, false); }
__device__ __forceinline__ void widen(const f32x4& a0, const f32x4& a1, bool, f32x4& xa, f32x4& xb) {
#pragma unroll
    for (int j = 0; j < 4; ++j) { const unsigned u0 = __float_as_uint(a0[j]), u1 = __float_as_uint(a1[j]);
        xa[j] = __uint_as_float(dpp_x8<0xC>(u0, u1));
        xb[j] = __uint_as_float(dpp_x8<0x3>(u1, u0)); }
}
__device__ __forceinline__ void widen_pk(const v4u& p0, const v4u& p1, v4u& xa, v4u& xb) {
    xa.x = dpp_x8<0xC>(p0.x, p1.x); xa.y = dpp_x8<0xC>(p0.y, p1.y); xa.z = dpp_x8<0xC>(p0.z, p1.z); xa.w = dpp_x8<0xC>(p0.w, p1.w);
    xb.x = dpp_x8<0x3>(p1.x, p0.x); xb.y = dpp_x8<0x3>(p1.y, p0.y); xb.z = dpp_x8<0x3>(p1.z, p0.z); xb.w = dpp_x8<0x3>(p1.w, p0.w);
}
__device__ __forceinline__ v4u pack8(const f32x4& v0, const f32x4& v1) { v4u w; w.x = pg8::cvt_pk_bf16(v0[0], v0[1]); w.y = pg8::cvt_pk_bf16(v0[2], v0[3]); w.z = pg8::cvt_pk_bf16(v1[0], v1[1]); w.w = pg8::cvt_pk_bf16(v1[2], v1[3]); return w; }
#ifndef THIN_NT
#define THIN_NT 1
#endif
#if THIN_NT
#define NT_LD(p) __builtin_nontemporal_load(p)
#define NT_ST(p, v) __builtin_nontemporal_store((v), (p))
#else
#define NT_LD(p) (*(p))
#define NT_ST(p, v) (*(p) = (v))
#endif
#ifndef EPI_NT
#define EPI_NT 1
#endif
#if EPI_NT
#define EPI_ST(p, v) __builtin_nontemporal_store((v), (p))
#else
#define EPI_ST(p, v) (*(p) = (v))
#endif
template <int MODE> struct EpiProj {
    static constexpr bool PERM = true; static constexpr bool ASM_BF16 = false; static constexpr int NST = 8;
    bf16* O;
    __device__ __forceinline__ void operator()(const f32x4 (&acc)[2][2][4][2], const Unit& u, int wr, int wc, int fr, int fq) const {
        const int colt = MODE == 0 ? (u.pn < 6 ? u.pn * 256 : (u.pn < 14 ? OGA + (u.pn - 6) * 256 : OCB + (u.pn - 14) * 256)) : 0;
        const float sc = MODE == 0 ? ((u.pn < 4) ? QSCALE / WIN_SCALE : ((u.pn >= 6 && u.pn < 14) ? -LOG2E / WIN_SCALE : 1.f / WIN_SCALE)) : 1.f;
        const bool hi8 = fr >= 8; const int row0 = u.pm * 256 + wr * 64 + (fr & 7), col0 = colt + wc * 64 + (hi8 ? 32 : 0) + 8 * fq;
        if (MODE == 1) {
            const int r0 = u.pm * 256 + wr * 64 + fr, c0 = OCC + u.pn * 128 + wc * 32 + 8 * fq;
#pragma unroll
            for (int ai = 0; ai < 2; ++ai)
#pragma unroll
                for (int m = 0; m < 4; ++m) EPI_ST((v4u*)(O + (size_t)(r0 + ai * 128 + m * 16) * DIN + c0), pack8(acc[ai][0][m][0] * acc[ai][1][m][0], acc[ai][0][m][1] * acc[ai][1][m][1]));
            return; }
#pragma unroll
        for (int ai = 0; ai < 2; ++ai)
#pragma unroll
            for (int m = 0; m < 4; ++m) { bf16* rowp = O + (size_t)(row0 + ai * 128 + m * 16) * DIN + col0;
                v4u xa, xb; widen_pk(pack8(acc[ai][0][m][0] * sc, acc[ai][0][m][1] * sc), pack8(acc[ai][1][m][0] * sc, acc[ai][1][m][1] * sc), xa, xb);
                EPI_ST((v4u*)rowp, xa); EPI_ST((v4u*)(rowp + 8 * DIN), xb); }
    }
};
#ifndef EG_D0
#define EG_D0 7
#endif
#ifndef EG_D1
#define EG_D1 3
#endif
template <int MODE> struct EpiGate {
    static constexpr bool PERM = true; static constexpr bool ASM_BF16 = (MODE == 1);   static constexpr int NST = 0;
    const bf16* proj; bf16* tmp; int gcol0;
    struct Step { v4u ga, gb, ta, tb; };
    __device__ __forceinline__ void operator()(const f32x4 (&acc)[2][2][4][2], const Unit& u, int wr, int wc, int fr, int fq) const {
        const bool hi8 = fr >= 8; const int row0 = u.pm * 256 + wr * 64 + (fr & 7), col0 = u.pn * 256 + wc * 64 + (hi8 ? 32 : 0) + 8 * fq;
        constexpr float SC = MODE == 0 ? 1.0f / (ATT_SCALE * WAO_SCALE) : 1.0f;
        constexpr int D = MODE == 0 ? EG_D0 : EG_D1;
        const char* gb_ = (const char*)proj; char* tb_ = (char*)tmp;
        const unsigned g0 = (unsigned)(row0 * DIN + gcol0 + col0) * 2u, t0 = (unsigned)(row0 * DM + col0) * 2u;
        Step q[D + 1];
        auto issue = [&](int s, Step& r) { const unsigned dr = (unsigned)((s >> 2) * 128 + (s & 3) * 16);
            r.ga = NT_LD((const v4u*)(gb_ + g0 + dr * (unsigned)(DIN * 2))); r.gb = NT_LD((const v4u*)(gb_ + g0 + (dr + 8u) * (unsigned)(DIN * 2)));
            if (MODE == 1) { r.ta = *(const v4u*)(tb_ + t0 + dr * (unsigned)(DM * 2)); r.tb = *(const v4u*)(tb_ + t0 + (dr + 8u) * (unsigned)(DM * 2)); } };
#pragma unroll
        for (int s = 0; s < D; ++s) issue(s, q[s]);
#pragma unroll
        for (int st = 0; st < 8; ++st) { const int ai = st >> 2, m = st & 3;
            if (st + D < 8) issue(st + D, q[(st + D) % (D + 1)]);
            const Step& c = q[st % (D + 1)];
            const unsigned dr = (unsigned)(ai * 128 + m * 16);
            f32x4 xa0, xb0, xa1, xb1; widen(acc[ai][0][m][0], acc[ai][1][m][0], hi8, xa0, xb0); widen(acc[ai][0][m][1], acc[ai][1][m][1], hi8, xa1, xb1);
#pragma unroll
            for (int s = 0; s < 2; ++s) {
                const f32x4 y0 = s ? xb0 : xa0, y1 = s ? xb1 : xa1; const v4u g4 = s ? c.gb : c.ga; float r[8], y[8];
                r[0] = bflo(g4.x); r[1] = bfhi(g4.x); r[2] = bflo(g4.y); r[3] = bfhi(g4.y); r[4] = bflo(g4.z); r[5] = bfhi(g4.z); r[6] = bflo(g4.w); r[7] = bfhi(g4.w);
#pragma unroll
                for (int k = 0; k < 4; ++k) { y[k] = y0[k]; y[4 + k] = y1[k]; }
#pragma unroll
                for (int k = 0; k < 8; ++k) r[k] = __builtin_amdgcn_exp2f(r[k] * -LOG2E);
#pragma unroll
                for (int k = 0; k < 8; ++k) r[k] = __builtin_fmaf(r[k], 1.0f / SC, 1.0f / SC);
#pragma unroll
                for (int k = 0; k < 8; ++k) r[k] = __builtin_amdgcn_rcpf(r[k]);
                if (MODE == 1) { const v4u t4 = s ? c.tb : c.ta; float tq[8];
                    tq[0] = bflo(t4.x); tq[1] = bfhi(t4.x); tq[2] = bflo(t4.y); tq[3] = bfhi(t4.y); tq[4] = bflo(t4.z); tq[5] = bfhi(t4.z); tq[6] = bflo(t4.w); tq[7] = bfhi(t4.w);
#pragma unroll
                    for (int k = 0; k < 8; ++k) r[k] = __builtin_fmaf(y[k], r[k], tq[k]);
                } else {
#pragma unroll
                    for (int k = 0; k < 8; ++k) r[k] = y[k] * r[k]; }
                v4u w; w.x = pg8::cvt_pk_bf16(r[0], r[1]); w.y = pg8::cvt_pk_bf16(r[2], r[3]); w.z = pg8::cvt_pk_bf16(r[4], r[5]); w.w = pg8::cvt_pk_bf16(r[6], r[7]);
                *(v4u*)(tb_ + t0 + (dr + 8u * s) * (unsigned)(DM * 2)) = w; }
        }
    }
};
struct EpiPlain {
    static constexpr bool PERM = true; static constexpr bool ASM_BF16 = false; static constexpr int NST = 8;
    bf16* tmp;
    __device__ __forceinline__ void operator()(const f32x4 (&acc)[2][2][4][2], const Unit& u, int wr, int wc, int fr, int fq) const {
        const bool hi8 = fr >= 8; const int row0 = u.pm * 256 + wr * 64 + (fr & 7), col0 = u.pn * 256 + wc * 64 + (hi8 ? 32 : 0) + 8 * fq;
        constexpr float sc = 1.0f / (ATT_SCALE * WAO_SCALE);
#pragma unroll
        for (int ai = 0; ai < 2; ++ai)
#pragma unroll
            for (int m = 0; m < 4; ++m) { bf16* rowp = tmp + (size_t)(row0 + ai * 128 + m * 16) * DM + col0;
                v4u xa, xb; widen_pk(pack8(acc[ai][0][m][0] * sc, acc[ai][0][m][1] * sc), pack8(acc[ai][1][m][0] * sc, acc[ai][1][m][1] * sc), xa, xb);
                *(v4u*)rowp = xa; *(v4u*)(rowp + 8 * DM) = xb; }
    }
};
#ifndef EG2_D
#define EG2_D 2
#endif
struct EpiGate2 {
    static constexpr bool PERM = true; static constexpr bool ASM_BF16 = true; static constexpr int NST = 0;
    const bf16* proj; bf16* tmp;
    struct Step { v4u ca, cb, aa, ab, ta, tb; };
    __device__ __forceinline__ void operator()(const f32x4 (&acc)[2][2][4][2], const Unit& u, int wr, int wc, int fr, int fq) const {
        const bool hi8 = fr >= 8; const int row0 = u.pm * 256 + wr * 64 + (fr & 7), col0 = u.pn * 256 + wc * 64 + (hi8 ? 32 : 0) + 8 * fq;
        constexpr int D = EG2_D;
        const char* gb_ = (const char*)proj; char* tb_ = (char*)tmp;
        const unsigned gc0 = (unsigned)(row0 * DIN + OGC + col0) * 2u, ga0 = (unsigned)(row0 * DIN + OGA + col0) * 2u, t0 = (unsigned)(row0 * DM + col0) * 2u;
        Step q[D + 1];
        auto issue = [&](int s, Step& r) { const unsigned dr = (unsigned)((s >> 2) * 128 + (s & 3) * 16);
            r.ca = NT_LD((const v4u*)(gb_ + gc0 + dr * (unsigned)(DIN * 2))); r.cb = NT_LD((const v4u*)(gb_ + gc0 + (dr + 8u) * (unsigned)(DIN * 2)));
            r.aa = NT_LD((const v4u*)(gb_ + ga0 + dr * (unsigned)(DIN * 2))); r.ab = NT_LD((const v4u*)(gb_ + ga0 + (dr + 8u) * (unsigned)(DIN * 2)));
            r.ta = *(const v4u*)(tb_ + t0 + dr * (unsigned)(DM * 2)); r.tb = *(const v4u*)(tb_ + t0 + (dr + 8u) * (unsigned)(DM * 2)); };
#pragma unroll
        for (int s = 0; s < D; ++s) issue(s, q[s]);
#pragma unroll
        for (int st = 0; st < 8; ++st) { const int ai = st >> 2, m = st & 3;
            if (st + D < 8) issue(st + D, q[(st + D) % (D + 1)]);
            const Step& c = q[st % (D + 1)];
            const unsigned dr = (unsigned)(ai * 128 + m * 16);
            f32x4 xa0, xb0, xa1, xb1; widen(acc[ai][0][m][0], acc[ai][1][m][0], hi8, xa0, xb0); widen(acc[ai][0][m][1], acc[ai][1][m][1], hi8, xa1, xb1);
#pragma unroll
            for (int s = 0; s < 2; ++s) {
                const f32x4 y0 = s ? xb0 : xa0, y1 = s ? xb1 : xa1; const v4u g4 = s ? c.cb : c.ca, a4 = s ? c.ab : c.aa, t4 = s ? c.tb : c.ta; float r[8], ra[8];
                ra[0] = bflo(a4.x); ra[1] = bfhi(a4.x); ra[2] = bflo(a4.y); ra[3] = bfhi(a4.y); ra[4] = bflo(a4.z); ra[5] = bfhi(a4.z); ra[6] = bflo(a4.w); ra[7] = bfhi(a4.w);
#pragma unroll
                for (int k = 0; k < 8; ++k) ra[k] = __builtin_amdgcn_exp2f(ra[k]);
#pragma unroll
                for (int k = 0; k < 8; ++k) ra[k] = __builtin_amdgcn_rcpf(1.0f + ra[k]);
                ra[0] *= bflo(t4.x); ra[1] *= bfhi(t4.x); ra[2] *= bflo(t4.y); ra[3] *= bfhi(t4.y); ra[4] *= bflo(t4.z); ra[5] *= bfhi(t4.z); ra[6] *= bflo(t4.w); ra[7] *= bfhi(t4.w);
                asm volatile("" ::: "memory");
                r[0] = bflo(g4.x); r[1] = bfhi(g4.x); r[2] = bflo(g4.y); r[3] = bfhi(g4.y); r[4] = bflo(g4.z); r[5] = bfhi(g4.z); r[6] = bflo(g4.w); r[7] = bfhi(g4.w);
#pragma unroll
                for (int k = 0; k < 8; ++k) r[k] = __builtin_amdgcn_exp2f(r[k]);
#pragma unroll
                for (int k = 0; k < 8; ++k) r[k] = __builtin_amdgcn_rcpf(1.0f + r[k]);
#pragma unroll
                for (int k = 0; k < 4; ++k) { r[k] = __builtin_fmaf(y0[k], r[k], ra[k]); r[4 + k] = __builtin_fmaf(y1[k], r[4 + k], ra[4 + k]); }
                v4u w; w.x = pg8::cvt_pk_bf16(r[0], r[1]); w.y = pg8::cvt_pk_bf16(r[2], r[3]); w.z = pg8::cvt_pk_bf16(r[4], r[5]); w.w = pg8::cvt_pk_bf16(r[6], r[7]);
                *(v4u*)(tb_ + t0 + (dr + 8u * s) * (unsigned)(DM * 2)) = w; }
        }
    }
};
#ifndef RESID_D
#define RESID_D 4
#endif
struct EpiResid {
    static constexpr bool PERM = true; static constexpr bool ASM_BF16 = true; static constexpr int NST = 8;
    bf16* out; int row_off;
    __device__ __forceinline__ void operator()(const f32x4 (&acc)[2][2][4][2], const Unit& u, int wr, int wc, int fr, int fq) const {
        const bool hi8 = fr >= 8; const int row0 = row_off + u.pm * 256 + wr * 64 + (fr & 7), col0 = u.pn * 256 + wc * 64 + (hi8 ? 32 : 0) + 8 * fq;
#pragma unroll
        for (int ai = 0; ai < 2; ++ai)
#pragma unroll
            for (int m = 0; m < 4; ++m) { bf16* rowp = out + (size_t)(row0 + ai * 128 + m * 16) * DM + col0;
                v4u xa, xb; widen_pk(pack8(acc[ai][0][m][0], acc[ai][0][m][1]), pack8(acc[ai][1][m][0], acc[ai][1][m][1]), xa, xb);
                EPI_ST((v4u*)rowp, xa); EPI_ST((v4u*)(rowp + 8 * DM), xb); }
    }
};
struct EpiSwiglu {
    static constexpr bool PERM = true; static constexpr bool ASM_BF16 = false; static constexpr int NST = 4;
    unsigned char* H;
    __device__ __forceinline__ void operator()(const f32x4 (&acc)[2][2][4][2], const Unit& u, int wr, int wc, int fr, int fq) const {
        const int rb0 = u.pm * 16 + wr * 4 + (fq & 1), tile0 = (u.pn * 4 + wc) * 512 + fr * 32 + (fq & ~1) * 8;
        constexpr float SI = 1.0f / (WGU_SCALE * PROBE_KREP);
        constexpr float C1 = -SI * LOG2E, KD = 1.0f / (SI * SI * H_SCALE);
#pragma unroll
        for (int ai = 0; ai < 2; ++ai)
#pragma unroll
            for (int m2 = 0; m2 < 4; m2 += 2) { v2u w[2];
#pragma unroll
                for (int mm = 0; mm < 2; ++mm) { const int m = m2 + mm; float t[8], gu[8];
#pragma unroll
                    for (int k = 0; k < 8; ++k) { const float G = acc[ai][0][m][k >> 2][k & 3], U = acc[ai][1][m][k >> 2][k & 3]; t[k] = (G * C1); gu[k] = (G * U); }
#pragma unroll
                    for (int k = 0; k < 8; ++k) t[k] = __builtin_amdgcn_exp2f(t[k]);
#pragma unroll
                    for (int k = 0; k < 8; ++k) t[k] = __builtin_fmaf(t[k], KD, KD);
#pragma unroll
                    for (int k = 0; k < 8; ++k) t[k] = __builtin_amdgcn_rcpf(t[k]);
#pragma unroll
                    for (int k = 0; k < 8; ++k) t[k] = (gu[k] * t[k]);
                    w[mm].x = pk4_fp8(t[0], t[1], t[2], t[3]); w[mm].y = pk4_fp8(t[4], t[5], t[6], t[7]); }
                const auto px = __builtin_amdgcn_permlane16_swap(w[0].x, w[1].x, false, false), py = __builtin_amdgcn_permlane16_swap(w[0].y, w[1].y, false, false);
                const v4u o = {px[0], py[0], px[1], py[1]};
                EPI_ST((v4u*)(H + (size_t)(rb0 + ai * 8 + m2) * (16 * DFF) + tile0), o); }
    }
};
struct EpiDown {
    static constexpr bool PERM = true; static constexpr bool ASM_BF16 = false; static constexpr int NST = 16;
    bf16* Y; const float* topval;
    __device__ __forceinline__ void operator()(const f32x4 (&acc)[2][2][4][2], const Unit& u, int wr, int wc, int fr, int fq) const {
        const bool hi8 = fr >= 8; const int row0 = u.pm * 256 + wr * 64 + (fr & 7), col0 = u.pn * 256 + wc * 64 + (hi8 ? 32 : 0) + 8 * fq;
        float tsc[2][4];
#pragma unroll
        for (int ai = 0; ai < 2; ++ai)
#pragma unroll
            for (int m = 0; m < 4; ++m) tsc[ai][m] = topval[u.pm * 256 + wr * 64 + fr + ai * 128 + m * 16];
#pragma unroll
        for (int ai = 0; ai < 2; ++ai)
#pragma unroll
            for (int m = 0; m < 4; ++m) { const int row = row0 + ai * 128 + m * 16; const float t = tsc[ai][m] * (1.0f / (H_SCALE * WDN_SCALE)); bf16* rowp = Y + (size_t)row * DM + col0;
                v4u xa, xb; widen_pk(pack8(acc[ai][0][m][0] * t, acc[ai][0][m][1] * t), pack8(acc[ai][1][m][0] * t, acc[ai][1][m][1] * t), xa, xb);
                EPI_ST((v4u*)rowp, xa); EPI_ST((v4u*)(rowp + 8 * DM), xb); }
    }
};

__device__ __forceinline__ void transpose_item(const float* __restrict__ Wblk, int N, bf16* dst, int ldo, LAS float* scr, int lane) {
#pragma unroll 8
    for (int i = 0; i < 32; ++i) { const int kk = 2 * i + (lane >> 5); scr[kk * 33 + (lane & 31)] = NT_LD(Wblk + (size_t)kk * N + (lane & 31)); }
    LDS_WAIT(); asm volatile("" ::: "memory");
    const int c = lane & 7;
#pragma unroll
    for (int j = 0; j < 4; ++j) { const int n = (lane >> 3) + 8 * j; const LAS float* s = scr + (8 * c) * 33 + n;
        v4u o; o.x = pk2(s[0 * 33], s[1 * 33]); o.y = pk2(s[2 * 33], s[3 * 33]); o.z = pk2(s[4 * 33], s[5 * 33]); o.w = pk2(s[6 * 33], s[7 * 33]);
        *(v4u*)(dst + (size_t)n * ldo + 8 * c) = o; }
    LDS_WAIT(); asm volatile("" ::: "memory");
}

__device__ __forceinline__ void transpose_item8(const float* __restrict__ Wblk, int N, unsigned char* dst, int ldo, float scale, LAS float* scr, int lane) {
#pragma unroll 8
    for (int i = 0; i < 32; ++i) { const int kk = 2 * i + (lane >> 5); scr[kk * 33 + (lane & 31)] = NT_LD(Wblk + (size_t)kk * N + (lane & 31)) * scale; }
    LDS_WAIT(); asm volatile("" ::: "memory");
    const int c = lane & 3;
#pragma unroll
    for (int j = 0; j < 2; ++j) { const int n = (lane >> 2) + 16 * j; const LAS float* s = scr + (16 * c) * 33 + n;
        v4u o; o.x = pk4_fp8(s[0 * 33], s[1 * 33], s[2 * 33], s[3 * 33]); o.y = pk4_fp8(s[4 * 33], s[5 * 33], s[6 * 33], s[7 * 33]);
        o.z = pk4_fp8(s[8 * 33], s[9 * 33], s[10 * 33], s[11 * 33]); o.w = pk4_fp8(s[12 * 33], s[13 * 33], s[14 * 33], s[15 * 33]);
        *(v4u*)(dst + (size_t)n * ldo + 16 * c) = o; }
    LDS_WAIT(); asm volatile("" ::: "memory");
}

struct Args { const float* in[17]; float* out; unsigned char* ws; int lo, hi; };
#define CAS __attribute__((address_space(4)))
__device__ __forceinline__ const void* karg(int byte_off) {
    const CAS char* kp = (const CAS char*)__builtin_amdgcn_kernarg_segment_ptr(); asm volatile("" : "+s"(kp)); return *(const void* const CAS*)(kp + byte_off); }

__device__ __forceinline__ f32x16 mfma32(bf16x8 a, bf16x8 b, f32x16 c) { return __builtin_amdgcn_mfma_f32_32x32x16_bf16(a, b, c, 0, 0, 0); }
__device__ __forceinline__ s16x4 vtr(LAS unsigned char* p) { return __builtin_bit_cast(s16x4, __builtin_amdgcn_ds_read_tr16_b64_v4i16((LAS s16x4*)p)); }
__device__ __forceinline__ void attn_dma_chunk(LAS unsigned char* lds, const bf16* __restrict__ proj, int bl, int g, int pc, int wave, int lane) {
    if (pc < 0 || pc >= SEQ / 128) return;
    const int slot = (pc + 1) & 3;
#pragma unroll
    for (int h = 0; h < 2; ++h) { const int q = wave + 8 * h, r = 8 * q + (lane >> 3), pch = lane & 7;
        const bf16* rowp = proj + (size_t)(bl * SEQ + pc * 128 + r) * DIN + g * 64;
        __builtin_amdgcn_global_load_lds((const unsigned*)(rowp + OK_ + ((pch ^ ((r >> 1) & 7)) << 3)), (LAS unsigned*)(lds + slot * 16384 + q * 1024), 16, 0, 0);
        __builtin_amdgcn_global_load_lds((const unsigned*)(rowp + OV + ((pch ^ (((r >> 1) & 1) << 2)) << 3)), (LAS unsigned*)(lds + 65536 + slot * 16384 + q * 1024), 16, 0, 0); }
}
__device__ __forceinline__ void attn_run(LAS unsigned char* lds, const bf16* __restrict__ proj, unsigned char* __restrict__ ao, const float* __restrict__ sink,
                                         int bl, int g, int n0, int lane, int wave) {
    const int ql = lane & 31, h5 = lane >> 5, rb = wave & 3, hp = wave >> 2;
    float slope2[2], sink2[2];
#pragma unroll
    for (int hh = 0; hh < 2; ++hh) { const int head = 4 * g + 2 * hp + hh; sink2[hh] = sink[head] * LOG2E; slope2[hh] = exp2f(-0.5f * (float)(head + 1)) * LOG2E; }
    const int sw = (ql >> 1) & 7;
    int koff[4];
#pragma unroll
    for (int ks = 0; ks < 4; ++ks) koff[ks] = ql * 128 + (((2 * ks + h5) ^ sw) << 4);
    const int i16 = lane & 15, g16 = (lane >> 4) & 1, bsw = (lane >> 3) & 1;
    const int vb0 = 65536 + (4 * h5 + (i16 >> 2)) * 128 + ((((2 * g16) + ((i16 & 3) >> 1)) ^ (4 * bsw)) << 4) + (i16 & 1) * 8;
    const int vb1 = vb0 ^ 64;
    const float qoff = (float)(ql - 4 * h5);
    const bf16* qbase = proj + (size_t)(bl * SEQ + rb * 32 + ql) * DIN + (4 * g + 2 * hp) * 64 + 8 * h5;
    asm volatile("s_waitcnt vmcnt(0) lgkmcnt(0)" ::: "memory"); __builtin_amdgcn_s_barrier(); asm volatile("" ::: "memory");
    attn_dma_chunk(lds, proj, bl, g, n0 - 1, wave, lane); attn_dma_chunk(lds, proj, bl, g, n0, wave, lane); attn_dma_chunk(lds, proj, bl, g, n0 + 1, wave, lane);
    bf16x8 qf[2][4];
#pragma unroll
    for (int hh = 0; hh < 2; ++hh)
#pragma unroll
        for (int ks = 0; ks < 4; ++ks) qf[hh][ks] = *(const bf16x8*)(qbase + (size_t)(n0 * 128) * DIN + hh * 64 + 16 * ks);
#pragma unroll 1
    for (int i = 0; i < 4; ++i) {
        const int n = n0 + i;
        asm volatile("s_waitcnt vmcnt(0) lgkmcnt(0)" ::: "memory"); __builtin_amdgcn_s_barrier(); asm volatile("" ::: "memory");
#pragma unroll
        for (int hh = 0; hh < 2; ++hh)
#pragma unroll
            for (int ks = 0; ks < 4; ++ks) asm volatile("" : "+v"(qf[hh][ks]));
        if (i < 3) attn_dma_chunk(lds, proj, bl, g, n + 2, wave, lane);
        const int tq = n * 128 + rb * 32 + ql;
        const int dlo = (n == 0) ? 4 - rb : 0, dhi = (n == SEQ / 128 - 1) ? 7 - rb : 8;
#define ATT_BOFF(dd) ((((n + ((rb + (dd)) >> 2)) & 3) * 16384) + (((rb + (dd)) & 3) * 4096))
#define ATT_LDK(dst, dd) do { const int bo_ = ATT_BOFF(dd); _Pragma("unroll") for (int ks = 0; ks < 4; ++ks) dst[ks] = *(const LAS bf16x8*)(lds + bo_ + koff[ks]); } while (0)
#define ATT_LDV(dst, dd) do { const int bo_ = ATT_BOFF(dd); _Pragma("unroll") for (int s = 0; s < 2; ++s) { \
            const s16x4 a0 = vtr(lds + vb0 + bo_ + s * 2048), a1 = vtr(lds + vb0 + bo_ + s * 2048 + 1024), c0 = vtr(lds + vb1 + bo_ + s * 2048), c1 = vtr(lds + vb1 + bo_ + s * 2048 + 1024); \
            dst[0][s] = __builtin_shufflevector(a0, a1, 0, 1, 2, 3, 4, 5, 6, 7); dst[1][s] = __builtin_shufflevector(c0, c1, 0, 1, 2, 3, 4, 5, 6, 7); } } while (0)
#pragma unroll
        for (int hh = 0; hh < 2; ++hh) {
            f32x16 o0, o1;
#pragma unroll
            for (int r = 0; r < 16; ++r) { o0[r] = 0.f; o1[r] = 0.f; }
            float mrun = sink2[hh], lrun = (h5 == 0) ? 1.f : 0.f;
            const float sl = slope2[hh], sl32 = 32.f * sl;
            bf16x8 kf[4], vf[2][2];
            f32x16 E, S;
            const float sl128 = 128.f * sl;
            float qoff_ = qoff; asm volatile("" : "+v"(qoff_));
#pragma unroll
            for (int r = 0; r < 16; ++r) E[r] = -sl * (qoff_ + (float)(128 - ((r & 3) + 8 * (r >> 2))));
            ATT_LDK(kf, dlo);
            S = mfma32(kf[0], qf[hh][0], E);
#pragma unroll
            for (int ks = 1; ks < 4; ++ks) S = mfma32(kf[ks], qf[hh][ks], S);
#pragma unroll 1
            for (int d = dlo; d <= dhi; ++d) {
                const int dn = d < dhi ? d + 1 : dhi;
                if (d == 4 && dn == 5) {
#pragma unroll
                    for (int ks = 0; ks < 4; ++ks) { v4u w = __builtin_bit_cast(v4u, qf[hh][ks]); w.x ^= 0x80008000u; w.y ^= 0x80008000u; w.z ^= 0x80008000u; w.w ^= 0x80008000u; qf[hh][ks] = __builtin_bit_cast(bf16x8, w); } }
                ATT_LDK(kf, dn);
                f32x16 Sn = mfma32(kf[0], qf[hh][0], E);
#pragma unroll
                for (int ks = 1; ks < 4; ++ks) Sn = mfma32(kf[ks], qf[hh][ks], Sn);
                const float cd = (d <= 4) ? sl32 * (float)d : -sl32 * (float)d, sg = (d <= 4) ? 1.f : -1.f;
                float mb;
                if (d <= 4) {
                    if (d == 0) {
#pragma unroll
                        for (int r = 0; r < 16; ++r) if (E[r] + sl128 < 0.f) S[r] = -INFINITY; }
                    if (d == 4) {
#pragma unroll
                        for (int r = 0; r < 16; ++r) S[r] = __builtin_fmaf(-2.f, fmaxf(E[r] + sl128, 0.f), S[r]); }
                    mb = S[0];
#pragma unroll
                    for (int r = 1; r < 16; ++r) mb = fmaxf(mb, S[r]);
                } else {
                    if (d == 8) {
#pragma unroll
                        for (int r = 0; r < 16; ++r) if (E[r] + sl128 > 0.f) S[r] = INFINITY; }
                    mb = S[0];
#pragma unroll
                    for (int r = 1; r < 16; ++r) mb = fminf(mb, S[r]);
                    mb = -mb;
                }
                { const auto pr = __builtin_amdgcn_permlane32_swap(__float_as_uint(mb), __float_as_uint(mb), false, false); mb = fmaxf(__uint_as_float(pr[0]), __uint_as_float(pr[1])); }
                const float mbt = mb + cd;
                if (!__all(mbt <= mrun + ATT_THR)) {
                    const float mn = fmaxf(mrun, mbt);
                    const float alpha = __builtin_amdgcn_exp2f(mrun - mn);
                    lrun *= alpha;
#pragma unroll
                    for (int r = 0; r < 16; ++r) { o0[r] *= alpha; o1[r] *= alpha; }
                    mrun = mn; }
                const float na = cd - mrun;
                ATT_LDV(vf, d);
                float ls = 0.f;
#pragma unroll
                for (int r = 0; r < 16; ++r) { const float p = __builtin_amdgcn_exp2f(__builtin_fmaf(sg, S[r], na)); S[r] = p; ls += p; }
                lrun += ls;
                bf16x8 pf[2];
#pragma unroll
                for (int s = 0; s < 2; ++s) { v4u w; w.x = pg8::cvt_pk_bf16(S[8 * s + 0], S[8 * s + 1]); w.y = pg8::cvt_pk_bf16(S[8 * s + 2], S[8 * s + 3]);
                    w.z = pg8::cvt_pk_bf16(S[8 * s + 4], S[8 * s + 5]); w.w = pg8::cvt_pk_bf16(S[8 * s + 6], S[8 * s + 7]); pf[s] = __builtin_bit_cast(bf16x8, w); }
#pragma unroll
                for (int s = 0; s < 2; ++s) { o0 = mfma32(vf[0][s], pf[s], o0); o1 = mfma32(vf[1][s], pf[s], o1); }
                S = Sn;
            }
            const int head = 4 * g + 2 * hp + hh;
            float lt = lrun; { const auto pr = __builtin_amdgcn_permlane32_swap(__float_as_uint(lrun), __float_as_uint(lrun), false, false); lt = __uint_as_float(pr[0]) + __uint_as_float(pr[1]); }
            const float inv = ATT_SCALE / lt;
            unsigned G[8];
#pragma unroll
            for (int rr = 0; rr < 4; ++rr) { G[rr] = pk4_fp8(o0[4 * rr] * inv, o0[4 * rr + 1] * inv, o0[4 * rr + 2] * inv, o0[4 * rr + 3] * inv);
                G[4 + rr] = pk4_fp8(o1[4 * rr] * inv, o1[4 * rr + 1] * inv, o1[4 * rr + 2] * inv, o1[4 * rr + 3] * inv); }
            unsigned W[8];
#pragma unroll
            for (int k = 0; k < 4; ++k) { const auto pr = __builtin_amdgcn_permlane32_swap(G[k], G[k + 4], false, false); W[2 * k] = pr[0]; W[2 * k + 1] = pr[1]; }
            unsigned char* orow = ao + (size_t)(bl * SEQ + tq) * DM + head * 64 + 32 * h5;
            *(v4u*)orow = (v4u){W[0], W[1], W[2], W[3]}; *(v4u*)(orow + 16) = (v4u){W[4], W[5], W[6], W[7]};
        }
#undef ATT_BOFF
#undef ATT_LDK
#undef ATT_LDV
        if (i < 3) {
#pragma unroll
            for (int hh = 0; hh < 2; ++hh)
#pragma unroll
                for (int ks = 0; ks < 4; ++ks) qf[hh][ks] = *(const bf16x8*)(qbase + (size_t)((n + 1) * 128) * DIN + hh * 64 + 16 * ks); }
    }
}

#ifndef STAGGER_TICKS
#define STAGGER_TICKS 0
#endif
__device__ __forceinline__ void stagger_start(int vcu) {
    if (STAGGER_TICKS > 0) { const unsigned long long t0 = __builtin_amdgcn_s_memrealtime(); const unsigned long long d = (unsigned long long)((vcu & 31) * STAGGER_TICKS / 32);
        while (__builtin_amdgcn_s_memrealtime() - t0 < d) __builtin_amdgcn_s_sleep(8); }
}
__global__ void __launch_bounds__(NWAVES * 64, 2) hybrid_fwd(Args args) {
    extern __shared__ __attribute__((aligned(16))) unsigned char lds_raw[];
    LAS unsigned char* lds = (LAS unsigned char*)lds_raw;
    volatile LAS unsigned* MISC = (volatile LAS unsigned*)(lds + MISC_OFF);
    const int G = gridDim.x; const int bx = blockIdx.x; const int vcu = (G % 8 == 0) ? (bx % 8) * (G / 8) + bx / 8 : bx; const int NGW = G * NWAVES;
#define KARG(T_, off) ((T_)karg(off))
#define IN_(i) KARG(const float*, 8 * (i))
#define OUT_() KARG(float*, 136)
#define WSP(T_, off) ((T_)((unsigned char*)karg(144) + (off)))

    for (int u = threadIdx.x; u < (LDS_BYTES - RING_BYTES) / 4; u += NWAVES * 64) ((LAS unsigned*)(lds + RING_BYTES))[u] = 0u;
    __syncthreads();
    const int lo = args.lo, hi = args.hi;
    XcdBarrier bar; bar.bar = WSP(unsigned*, WS_CTL) + CW_BAR; bar.x = 0; bar.st = nullptr;
    if (hi - lo > 1) bar = xcd_barrier_post(WSP(unsigned*, WS_CTL) + CW_BAR, MISC + 8);
    int s = 0;
#define STEP_BEGIN(site) if (lo <= s && s < hi) { for (int rep_ = 0; rep_ < 1 + ((REPEAT_MASK >> (site)) & 1); ++rep_) { int tid_ = threadIdx.x; asm volatile("" : "+v"(tid_)); const int tid = tid_, lane = tid & 63, wave = __builtin_amdgcn_readfirstlane(tid >> 6), gw = vcu * NWAVES + wave; (void)lane; (void)gw;
#define STEP_END   } if (s + 1 < hi) xcd_barrier(bar); } ++s;

    STEP_BEGIN(0)
    {
        LAS float* scr = (LAS float*)(lds + wave * 16384);
        constexpr int I_IN = (DM / 64) * (SRC_DIN / 32), I_SQ = (DM / 64) * (DM / 32);
        constexpr int NITEMS = I_IN + 3 * I_SQ;
        for (int it = gw; it < NITEMS; it += NGW) {
            int r = it;
            if (r < I_IN) { const int nblk = SRC_DIN / 32, kb = r / nblk, nb = r % nblk, n0 = 32 * nb; const float* W = IN_(3) + (size_t)(64 * kb) * SRC_DIN + n0;
                if (n0 >= S_CC && n0 < S_GA) {
                    const int which = n0 >= S_CX, chn = n0 - (which ? S_CX : S_CC); const int orow = (chn >> 7) * 256 + ((chn & 127) >> 5) * 64 + which * 32;
                    transpose_item(W, SRC_DIN, WSP(bf16*, WS_WINC) + (size_t)orow * DM + 64 * kb, DM, scr, lane); }
                else { const int orow8 = n0 < S_CB ? n0 : (n0 >= S_GA ? n0 - NGAT : 3584 + (n0 - S_CB));
                    transpose_item8(W, SRC_DIN, WSP(unsigned char*, WS_WIN8) + (size_t)orow8 * DM + 64 * kb, DM, WIN_SCALE, scr, lane); }
                continue; } r -= I_IN;
            { const int which = r / I_SQ, q = r % I_SQ, nblk = DM / 32, kb = q / nblk, nb = q % nblk;
                const float* W = which == 0 ? IN_(6) : (which == 1 ? IN_(7) : IN_(8));
                bf16* dst = which == 2 ? WSP(bf16*, WS_WOUT) + (size_t)(32 * nb) * DM + 64 * kb : WSP(bf16*, WS_WAC) + (size_t)(32 * nb) * (2 * DM) + which * DM + 64 * kb;
                if (which == 0) transpose_item8(W + (size_t)(64 * kb) * DM + 32 * nb, DM, WSP(unsigned char*, WS_WAO8) + (size_t)(32 * nb) * DM + 64 * kb, DM, WAO_SCALE, scr, lane);
                else transpose_item(W + (size_t)(64 * kb) * DM + 32 * nb, DM, dst, which == 2 ? DM : 2 * DM, scr, lane); }
        }
        const float* x = IN_(0); const float* ln0_g = IN_(1); const float* ln0_b = IN_(2); float* stats0 = WSP(float*, WS_STATS0); bf16* XN = WSP(bf16*, WS_XN); unsigned char* XN8 = WSP(unsigned char*, WS_XN8);
        f32x4 gv[4], bv[4];
#pragma unroll
        for (int j = 0; j < 4; ++j) { gv[j] = *(const f32x4*)(ln0_g + 4 * lane + 256 * j); bv[j] = *(const f32x4*)(ln0_b + 4 * lane + 256 * j); }
        for (int m = gw; m < T; m += NGW) {
            const f32x4* xr = (const f32x4*)(x + (size_t)m * DM) + lane;
            f32x4 v[4]; float sm = 0.f;
#pragma unroll
            for (int j = 0; j < 4; ++j) { v[j] = NT_LD(xr + 64 * j); sm += (v[j].x + v[j].y) + (v[j].z + v[j].w); }
            const float mean = wave_sum(sm) * (1.f / DM); float s2 = 0.f;
#pragma unroll
            for (int j = 0; j < 4; ++j) { v[j] = v[j] - mean; s2 += (v[j].x * v[j].x + v[j].y * v[j].y) + (v[j].z * v[j].z + v[j].w * v[j].w); }
            const float rstd = 1.f / sqrtf(wave_sum(s2) * (1.f / DM) + LN_EPS);
            if (lane == 0) *(f32x2*)(stats0 + (size_t)m * 2) = (f32x2){mean, rstd};
            v2u* o8 = (v2u*)(XN + (size_t)m * DM) + lane;
#pragma unroll
            for (int j = 0; j < 4; ++j) { const f32x4 y = v[j] * rstd * gv[j] + bv[j]; v2u w; w.x = pk2(y.x, y.y); w.y = pk2(y.z, y.w); o8[64 * j] = w;
                ((unsigned*)(XN8 + (size_t)m * DM))[lane + 64 * j] = pk4_fp8(y.x, y.y, y.z, y.w); }
        }
    }
    STEP_END

#pragma unroll 1
    for (int c = 0; c < NCHUNK; ++c) {
        STEP_BEGIN(1)
        {
            { pg8::Gemm g{WSP(unsigned char*, WS_XN8) + (size_t)c * TC * DM, WSP(unsigned char*, WS_WIN8), DM, DM, DM / 128}; pg8::StaticOrderT<TC / 256, NF8 / 256> S; S.init(G, bx);
              EpiProj<0> E{WSP(bf16*, WS_PROJ)};
              pg8::gemm_phase<EpiProj<0>, pg8::StaticOrderT<TC / 256, NF8 / 256>, true, true>(lds, g, S, E); }
            { pg8::Gemm g{WSP(bf16*, WS_XN) + (size_t)c * TC * DM, WSP(bf16*, WS_WINC), DM * 2, DM * 2, DM / 64}; pg8::StaticOrderT<TC / 256, NCV / 256> S; S.init(G, bx);
              EpiProj<1> E{WSP(bf16*, WS_PROJ)};
              pg8::gemm_phase<EpiProj<1>, pg8::StaticOrderT<TC / 256, NCV / 256>, true>(lds, g, S, E); }
        }
        STEP_END
        STEP_BEGIN(2)
        {
            const bf16* PROJ = WSP(const bf16*, WS_PROJ); bf16* CONV = (bf16*)OUT_();
            constexpr int NRUN = CBATCH * 4 * (SEQ / 512);
            { const float* attn_sink = IN_(5);
              for (int rp = 0; rp < 1 + ((REPEAT_MASK >> 16) & 1); ++rp)
              for (int u = vcu; u < NRUN; u += G) attn_run(lds, PROJ, WSP(unsigned char*, WS_ATT8), attn_sink, u >> 4, (u >> 2) & 3, (u & 3) * 4, lane, wave); }
            asm volatile("s_waitcnt vmcnt(0) lgkmcnt(0)" ::: "memory"); __builtin_amdgcn_s_barrier(); asm volatile("" ::: "memory");
            const int seg = tid >> 7, cg = tid & 127, ch = cg * 8;
            float w0[8], w1[8], w2[8];
            { const float* conv_w = IN_(4);
#pragma unroll
              for (int j = 0; j < 8; ++j) { w0[j] = conv_w[ch + j]; w1[j] = conv_w[DM + ch + j]; w2[j] = conv_w[2 * DM + ch + j]; } }
            for (int rp = 0; rp < 1 + ((REPEAT_MASK >> 17) & 1); ++rp)
            for (int it = vcu; it < TC / 32; it += G) {
                const int t0 = it * 32 + seg * 8;
                const int sq0 = t0 & (SEQ - 1);
                v4u uv[10], cbv[8];
#pragma unroll
                for (int i = 0; i < 10; ++i) { const int sp = sq0 - 1 + i; const bool ok = (sp >= 0) && (sp < SEQ);
                    uv[i] = NT_LD((const v4u*)(PROJ + (size_t)(ok ? t0 - 1 + i : t0) * DIN + OCC + ch)); }
#pragma unroll
                for (int i = 0; i < 8; ++i) cbv[i] = NT_LD((const v4u*)(PROJ + (size_t)(t0 + i) * DIN + OCB + ch));
                float um[8], uc[8], un[8];
                auto mk_u = [&](int i, float (&uu)[8]) { const v4u a = uv[i]; const int sp = sq0 - 1 + i; const float okf = ((sp >= 0) && (sp < SEQ)) ? 1.f : 0.f;
                    uu[0] = bflo(a.x) * okf; uu[1] = bfhi(a.x) * okf; uu[2] = bflo(a.y) * okf; uu[3] = bfhi(a.y) * okf;
                    uu[4] = bflo(a.z) * okf; uu[5] = bfhi(a.z) * okf; uu[6] = bflo(a.w) * okf; uu[7] = bfhi(a.w) * okf; };
                mk_u(0, um); mk_u(1, uc);
#pragma unroll
                for (int i = 0; i < 8; ++i) {
                    mk_u(i + 2, un);
                    const v4u cb = cbv[i];
                    float y[8];
#pragma unroll
                    for (int j = 0; j < 8; ++j) y[j] = w0[j] * um[j] + w1[j] * uc[j] + w2[j] * un[j];
                    y[0] *= bflo(cb.x); y[1] *= bfhi(cb.x); y[2] *= bflo(cb.y); y[3] *= bfhi(cb.y); y[4] *= bflo(cb.z); y[5] *= bfhi(cb.z); y[6] *= bflo(cb.w); y[7] *= bfhi(cb.w);
                    v4u w; w.x = pk2(y[0], y[1]); w.y = pk2(y[2], y[3]); w.z = pk2(y[4], y[5]); w.w = pk2(y[6], y[7]);
                    NT_ST((v4u*)(CONV + (size_t)(t0 + i) * DM + ch), w);
#pragma unroll
                    for (int j = 0; j < 8; ++j) { um[j] = uc[j]; uc[j] = un[j]; }
                }
            }
        }
        STEP_END
        STEP_BEGIN(3)
        {
            { pg8::Gemm g{WSP(unsigned char*, WS_ATT8), WSP(unsigned char*, WS_WAO8), DM, DM, DM / 128}; pg8::StaticOrderT<TC / 256, DM / 256> S; S.init(G, bx);
              EpiPlain E{(bf16*)OUT_() + (size_t)T * DM};
              pg8::gemm_phase<EpiPlain, pg8::StaticOrderT<TC / 256, DM / 256>, true, true>(lds, g, S, E); }
            { pg8::Gemm g{(const bf16*)OUT_(), WSP(bf16*, WS_WAC) + DM, 2 * DM, 4 * DM, DM / 64}; pg8::StaticOrderT<TC / 256, DM / 256> S; S.init(G, bx);
              EpiGate2 E{WSP(const bf16*, WS_PROJ), (bf16*)OUT_() + (size_t)T * DM};
              pg8::gemm_phase<EpiGate2, pg8::StaticOrderT<TC / 256, DM / 256>, true>(lds, g, S, E); }
        }
        STEP_END
    }

    STEP_BEGIN(4)
    {
        pg8::Gemm g{(const bf16*)OUT_() + (size_t)T * DM, WSP(bf16*, WS_WOUT), DM * 2, DM * 2, DM / 64}; pg8::StaticOrderT<TC / 256, DM / 256> S; S.init(G, bx);
        EpiResid E{WSP(bf16*, WS_PROJ), (NCHUNK - 1) * TC};
        pg8::gemm_phase<EpiResid, pg8::StaticOrderT<TC / 256, DM / 256>, true>(lds, g, S, E);
    }
    STEP_END

    STEP_BEGIN(5)
    {
        LAS float* wr_l = (LAS float*)lds;
        { const float* w_router = IN_(11);
          for (int i = tid; i < DM * NE; i += NWAVES * 64) { const int k = i >> 4, e = i & 15; wr_l[e * DM + k] = w_router[i]; } }
        __syncthreads();
        const float* ln1_g = IN_(9); const float* ln1_b = IN_(10); const bf16* yb = WSP(const bf16*, WS_PROJ); bf16* XN = WSP(bf16*, WS_XN); float* aff = WSP(float*, WS_AFF); unsigned char* X8 = WSP(unsigned char*, WS_XN8);
        LAS float* gb_l = (LAS float*)(lds + 65536);
        for (int i = tid; i < DM; i += NWAVES * 64) { gb_l[i] = ln1_g[i]; gb_l[DM + i] = ln1_b[i]; }
        __syncthreads();
        const bool h32 = (lane & 32) != 0, h16 = (lane & 16) != 0, h8 = (lane & 8) != 0, h4 = (lane & 4) != 0, h2 = (lane & 2) != 0;
        auto logits_out = [&](float (&w16)[16], int mrow) {
            float w8[8], w4[4], w2[2];
#pragma unroll
            for (int i = 0; i < 8; ++i) w8[i] = (h16 ? w16[8 + i] : w16[i]) + __shfl_xor(h16 ? w16[i] : w16[8 + i], 16);
#pragma unroll
            for (int i = 0; i < 4; ++i) w4[i] = (h8 ? w8[4 + i] : w8[i]) + __shfl_xor(h8 ? w8[i] : w8[4 + i], 8);
#pragma unroll
            for (int i = 0; i < 2; ++i) w2[i] = (h4 ? w4[2 + i] : w4[i]) + __shfl_xor(h4 ? w4[i] : w4[2 + i], 4);
            float lg = (h2 ? w2[1] : w2[0]) + __shfl_xor(h2 ? w2[0] : w2[1], 2);
            lg += __shfl_xor(lg, 1);
            float mx = lg;
#pragma unroll
            for (int o = 2; o < 32; o <<= 1) mx = fmaxf(mx, __shfl_xor(mx, o));
            const float ex = expf(lg - mx); float den = ex;
#pragma unroll
            for (int o = 2; o < 32; o <<= 1) den += __shfl_xor(den, o);
            if ((lane & 1) == 0) aff[(size_t)(mrow + (lane >> 5)) * NE + ((lane >> 1) & 15)] = ex / den; };
        v2u py[4][4], px[4][4];
        auto issue_rows = [&](int m0n) __attribute__((always_inline)) {
#pragma unroll
            for (int r = 0; r < 4; ++r) { const v2u* yr = (const v2u*)(yb + (size_t)(m0n + r) * DM) + lane; const v2u* xr = (const v2u*)(XN + (size_t)(m0n + r) * DM) + lane;
#pragma unroll
                for (int j = 0; j < 4; ++j) { py[r][j] = NT_LD(yr + 64 * j); px[r][j] = NT_LD(xr + 64 * j); } } };
        if (4 * gw < T) issue_rows(4 * gw);
        for (int m0 = 4 * gw; m0 < T; m0 += 4 * NGW) {
            f32x4 v[4][4];
#pragma unroll
            for (int r = 0; r < 4; ++r)
#pragma unroll
                for (int j = 0; j < 4; ++j) v[r][j] = (f32x4){bflo(px[r][j].x), bfhi(px[r][j].x), bflo(px[r][j].y), bfhi(px[r][j].y)} * ALPHA + (f32x4){bflo(py[r][j].x), bfhi(py[r][j].x), bflo(py[r][j].y), bfhi(py[r][j].y)};
            asm volatile("" ::: "memory");
            if (m0 + 4 * NGW < T) issue_rows(m0 + 4 * NGW);
#pragma unroll
            for (int r = 0; r < 4; ++r) { float sm = 0.f;
#pragma unroll
                for (int j = 0; j < 4; ++j) sm += (v[r][j].x + v[r][j].y) + (v[r][j].z + v[r][j].w);
                const float mean = wave_sum(sm) * (1.f / DM); float s2 = 0.f;
#pragma unroll
                for (int j = 0; j < 4; ++j) { v[r][j] = v[r][j] - mean; s2 += (v[r][j].x * v[r][j].x + v[r][j].y * v[r][j].y) + (v[r][j].z * v[r][j].z + v[r][j].w * v[r][j].w); }
                const float rstd = 1.f / sqrtf(wave_sum(s2) * (1.f / DM) + LN_EPS);
                v2u* o8 = (v2u*)(XN + (size_t)(m0 + r) * DM) + lane;
#pragma unroll
                for (int j = 0; j < 4; ++j) { const f32x4 gq = *(const LAS f32x4*)(gb_l + 4 * lane + 256 * j), bq = *(const LAS f32x4*)(gb_l + DM + 4 * lane + 256 * j); v[r][j] = v[r][j] * rstd * gq + bq; v2u w; w.x = pk2(v[r][j].x, v[r][j].y); w.y = pk2(v[r][j].z, v[r][j].w); o8[64 * j] = w;
                    ((unsigned*)(X8 + (size_t)(m0 + r) * DM))[lane + 64 * j] = pk4_fp8(v[r][j].x, v[r][j].y, v[r][j].z, v[r][j].w); } }
            float wA[16], wB[16];
#pragma unroll
            for (int e = 0; e < NE; ++e) { float a0 = 0.f, a1 = 0.f, a2 = 0.f, a3 = 0.f;
#pragma unroll
                for (int j = 0; j < 4; ++j) { const f32x4 wv = *(const LAS f32x4*)(wr_l + e * DM + 4 * lane + 256 * j);
#pragma unroll
                    for (int c = 0; c < 4; ++c) { a0 = __builtin_fmaf(v[0][j][c], wv[c], a0); a1 = __builtin_fmaf(v[1][j][c], wv[c], a1); a2 = __builtin_fmaf(v[2][j][c], wv[c], a2); a3 = __builtin_fmaf(v[3][j][c], wv[c], a3); } }
                wA[e] = (h32 ? a1 : a0) + __shfl_xor(h32 ? a0 : a1, 32);
                wB[e] = (h32 ? a3 : a2) + __shfl_xor(h32 ? a2 : a3, 32);
                if (e & 1) asm volatile("" ::: "memory"); }
            logits_out(wA, m0); logits_out(wB, m0 + 2);
        }
    }
    STEP_END

    STEP_BEGIN(6)
    {
        if (wave < 2) {
            const float* aff = WSP(const float*, WS_AFF); float* topval = WSP(float*, WS_TOPVAL); short* inv = WSP(short*, WS_INV); int* tokidx = WSP(int*, WS_TOKIDX);
            for (int u = vcu * 2 + wave; u < BATCH * NE; u += G * 2) {
                const int b = u >> 4, e = u & 15;
                unsigned key[32];
#pragma unroll
                for (int i = 0; i < 32; ++i) key[i] = __float_as_uint(aff[(size_t)(b * SEQ + lane + 64 * i) * NE + e]);
                unsigned thr = 0u;
                for (int bit = 30; bit >= 0; --bit) {
                    const unsigned cand = thr | (1u << bit); int cnt = 0;
#pragma unroll
                    for (int i = 0; i < 32; ++i) cnt += __popcll(__ballot(key[i] >= cand));
                    if (cnt >= CAP) thr = cand;
                }
                int ngt = 0;
#pragma unroll
                for (int i = 0; i < 32; ++i) ngt += __popcll(__ballot(key[i] > thr));
                const int need = CAP - ngt;
                int selb = 0, tieb = 0;
                const unsigned long long below = (1ull << lane) - 1ull;
                const size_t sbase = ((size_t)e * BATCH + b) * CAP;
#pragma unroll
                for (int i = 0; i < 32; ++i) {
                    const bool gt = key[i] > thr, eq = key[i] == thr;
                    const unsigned long long beq = __ballot(eq);
                    const int trank = tieb + __popcll(beq & below);
                    const bool sel = gt || (eq && trank < need);
                    const unsigned long long bsel = __ballot(sel);
                    const int cpos = selb + __popcll(bsel & below);
                    const int t = lane + 64 * i;
                    if (sel) { tokidx[sbase + cpos] = t; topval[sbase + cpos] = __uint_as_float(key[i]); }
                    inv[(size_t)(b * SEQ + t) * NE + e] = sel ? (short)cpos : (short)-1;
                    selb += __popcll(bsel); tieb += __popcll(beq);
                }
            }
        } else {
            LAS float* scr = (LAS float*)(lds + wave * 16384);
            constexpr int I_GU = (DM / 64) * (DFF / 32), I_DN = (DFF / 64) * (DM / 32), NITEMS = NE * (2 * I_GU + I_DN);
            for (int it = vcu * 6 + (wave - 2); it < NITEMS; it += G * 6) {
                const int e = it / (2 * I_GU + I_DN); int r = it - e * (2 * I_GU + I_DN);
                if (r < 2 * I_GU) { const int which = r / I_GU, q = r % I_GU, nblk = DFF / 32, kb = q / nblk, nb = q % nblk, n0 = 32 * nb;
                    const float* W = (which == 0 ? IN_(12) : IN_(13)) + (size_t)e * DM * DFF;
                    const int orow = (n0 >> 7) * 256 + ((n0 & 127) >> 5) * 64 + which * 32;
                    transpose_item8(W + (size_t)(64 * kb) * DFF + n0, DFF, WSP(unsigned char*, WS_WGU) + ((size_t)e * (2 * DFF) + orow) * DM + 64 * kb, DM, WGU_SCALE, scr, lane); continue; }
                r -= 2 * I_GU;
                { const int nblk = DM / 32, kb = r / nblk, nb = r % nblk;
                  transpose_item8(IN_(14) + (size_t)e * DFF * DM + (size_t)(64 * kb) * DM + 32 * nb, DM, WSP(unsigned char*, WS_WDN) + ((size_t)e * DM + 32 * nb) * DFF + 64 * kb, DFF, WDN_SCALE, scr, lane); }
            }
        }
    }
    STEP_END

    STEP_BEGIN(7)
    {
        pg8::Gemm g{WSP(unsigned char*, WS_XN8), WSP(unsigned char*, WS_WGU), DM, DM, DM / 128, WSP(const int*, WS_TOKIDX), TAB_OFF}; pg8::StaticOrderT<MSLOT / 256, 2 * DFF / 256, 5> S; S.init(G, bx);
        EpiSwiglu E{WSP(unsigned char*, WS_H)};
        pg8::gemm_phase<EpiSwiglu, pg8::StaticOrderT<MSLOT / 256, 2 * DFF / 256, 5>, true, true, PROBE_KREP, PROBE_EPIREP, true>(lds, g, S, E);
    }
    STEP_END
    STEP_BEGIN(8)
    {
        pg8::Gemm g{WSP(unsigned char*, WS_H), WSP(unsigned char*, WS_WDN), DFF, DFF, DFF / 128}; pg8::StaticOrderT<MSLOT / 256, DM / 256, 5> S; S.init(G, bx);
        EpiDown E{WSP(bf16*, WS_YE), WSP(const float*, WS_TOPVAL)};
        pg8::gemm_phase<EpiDown, pg8::StaticOrderT<MSLOT / 256, DM / 256, 5>, true, true, 1, 1, false, true>(lds, g, S, E);
    }
    STEP_END

    STEP_BEGIN(9)
    {
        if (PROBE_MFMA > 0) { pg8::v8i_t pa, pb; f32x4 pc0 = (f32x4){0.f, 0.f, 0.f, 0.f}, pc1 = pc0, pc2 = pc0, pc3 = pc0;
#pragma unroll
            for (int q = 0; q < 8; ++q) { pa[q] = 0x38383838 + lane; pb[q] = 0x3c3c3c3c - lane; }
#pragma unroll 1
            for (int k = 0; k < PROBE_MFMA / 4; ++k) { asm volatile("v_mfma_f32_16x16x128_f8f6f4 %0, %4, %5, %0\n\tv_mfma_f32_16x16x128_f8f6f4 %1, %4, %5, %1\n\tv_mfma_f32_16x16x128_f8f6f4 %2, %4, %5, %2\n\tv_mfma_f32_16x16x128_f8f6f4 %3, %4, %5, %3"
                : "+v"(pc0), "+v"(pc1), "+v"(pc2), "+v"(pc3) : "v"(pa), "v"(pb)); }
            asm volatile("s_nop 15\n\ts_nop 15" :: "v"(pc0), "v"(pc1), "v"(pc2), "v"(pc3)); }
        const float* ln2_g = IN_(15); const float* ln2_b = IN_(16);
        float* outp = OUT_(); const bf16* XN = WSP(const bf16*, WS_XN); const short* inv = WSP(const short*, WS_INV); const bf16* YE = WSP(const bf16*, WS_YE);
        f32x4 g2[4], b2[4];
#pragma unroll
        for (int j = 0; j < 4; ++j) { g2[j] = *(const f32x4*)(ln2_g + 4 * lane + 256 * j); b2[j] = *(const f32x4*)(ln2_b + 4 * lane + 256 * j); }
        v2u xc[4], xn_[4]; int slotc, slotn;
#pragma unroll
        for (int j = 0; j < 4; ++j) xc[j] = ((const v2u*)(XN + (size_t)gw * DM) + lane)[64 * j];
        slotc = (lane < NE) ? (int)inv[(size_t)gw * NE + lane] : -1;
        for (int m = gw; m < T; m += NGW) {
            f32x4* yr = (f32x4*)(outp + (size_t)m * DM) + lane;
            const int mn = (m + NGW < T) ? m + NGW : m;
#pragma unroll
            for (int j = 0; j < 4; ++j) xn_[j] = ((const v2u*)(XN + (size_t)mn * DM) + lane)[64 * j];
            slotn = (lane < NE) ? (int)inv[(size_t)mn * NE + lane] : -1;
            f32x4 v[4];
#pragma unroll
            for (int j = 0; j < 4; ++j) { const v2u w = xc[j]; v[j].x = bflo(w.x) * ALPHA; v[j].y = bfhi(w.x) * ALPHA; v[j].z = bflo(w.y) * ALPHA; v[j].w = bfhi(w.y) * ALPHA; }
            const int b = m >> 11;
            unsigned long long mk = __ballot(slotc >= 0);
            while (mk) {
                int ee[4], cp[4];
#pragma unroll
                for (int q = 0; q < 4; ++q) { ee[q] = -1; cp[q] = 0; if (mk) { ee[q] = __ffsll((long long)mk) - 1; mk &= mk - 1; cp[q] = __builtin_amdgcn_readlane(slotc, ee[q]); } }
                v2u w4[4][4];
#pragma unroll
                for (int q = 0; q < 4; ++q) if (ee[q] >= 0) { const v2u* yp = (const v2u*)(YE + ((size_t)(ee[q] * BATCH + b) * CAP + cp[q]) * DM) + lane;
#pragma unroll
                    for (int j = 0; j < 4; ++j) w4[q][j] = NT_LD(yp + 64 * j); }
#pragma unroll
                for (int q = 0; q < 4; ++q) if (ee[q] >= 0) {
#pragma unroll
                    for (int j = 0; j < 4; ++j) { const v2u w = w4[q][j]; v[j].x += bflo(w.x); v[j].y += bfhi(w.x); v[j].z += bflo(w.y); v[j].w += bfhi(w.y); } }
            }
            float sm = 0.f;
#pragma unroll
            for (int j = 0; j < 4; ++j) sm += (v[j].x + v[j].y) + (v[j].z + v[j].w);
            const float mean = wave_sum(sm) * (1.f / DM); float s2 = 0.f;
#pragma unroll
            for (int j = 0; j < 4; ++j) { v[j] = v[j] - mean; s2 += (v[j].x * v[j].x + v[j].y * v[j].y) + (v[j].z * v[j].z + v[j].w * v[j].w); }
            const float rstd = 1.f / sqrtf(wave_sum(s2) * (1.f / DM) + LN_EPS);
#pragma unroll
            for (int j = 0; j < 4; ++j) NT_ST(yr + 64 * j, v[j] * rstd * g2[j] + b2[j]);
#pragma unroll
            for (int j = 0; j < 4; ++j) xc[j] = xn_[j];
            slotc = slotn;
        }
    }
    STEP_END
#undef STEP_BEGIN
#undef STEP_END
}

constexpr int NSTEPS = 1 + NCHUNK * 3 + 1 + 2 + 2 + 1;

extern "C" void kernel_launch(void* const* d_in, const int* in_sizes, int n_in, void* d_out, int out_size, void* d_ws, size_t ws_size, hipStream_t stream) {
    static int grid = 0;
    if (grid == 0) {
        if (n_in != 17 || in_sizes[0] != T * DM || out_size != T * DM || ws_size < WS_END) { fprintf(stderr, "kernel_launch: unexpected shapes / workspace (%zu < %zu); nothing launched\n", ws_size, (size_t)WS_END); grid = -1; return; }
        int dev = 0, cus = 0, per_cu = 0;
        if (hipGetDevice(&dev) != hipSuccess || hipDeviceGetAttribute(&cus, hipDeviceAttributeMultiprocessorCount, dev) != hipSuccess) { grid = -1; return; }
        if (hipFuncSetAttribute((const void*)hybrid_fwd, hipFuncAttributeMaxDynamicSharedMemorySize, LDS_BYTES) != hipSuccess) { fprintf(stderr, "kernel_launch: hipFuncSetAttribute failed\n"); grid = -1; return; }
        if (hipOccupancyMaxActiveBlocksPerMultiprocessor(&per_cu, (const void*)hybrid_fwd, NWAVES * 64, LDS_BYTES) != hipSuccess || per_cu < 1)
            fprintf(stderr, "kernel_launch: occupancy query reports %d workgroups per CU\n", per_cu);
        (void)hipGetLastError();
        grid = cus;
    }
    if (grid < 0) return;
    (void)hipMemsetAsync((char*)d_ws + WS_CTL, 0, CTL_ZERO_BYTES, stream);
    Args a{};
    for (int i = 0; i < 17; ++i) a.in[i] = (const float*)d_in[i];
    a.out = (float*)d_out; a.ws = (unsigned char*)d_ws;
#if ONE_LAUNCH
    a.lo = 0; a.hi = NSTEPS;
    hipLaunchKernelGGL(hybrid_fwd, dim3(grid), dim3(NWAVES * 64), LDS_BYTES, stream, a);
#else
    for (int st = 0; st < NSTEPS; ++st) { a.lo = st; a.hi = st + 1; hipLaunchKernelGGL(hybrid_fwd, dim3(grid), dim3(NWAVES * 64), LDS_BYTES, stream, a); }
#endif
}
```
